# Optimizing an MI355X kernel written in HIP

```python
import math
import jax, jax.numpy as jnp
from jax import lax
import numpy as np

D_MODEL = 4096
BATCH = 4
SEQ = 2048
DEPTH = 2
DEC_BATCH = 16
DEC_SEQ = 16
PAST_LEN = 2048

CHUNK = 64
Q_BLOCK = 128
FOX_HEADS = 16
FOX_HEAD_DIM = 128
FOX_WIDTH = FOX_HEADS * FOX_HEAD_DIM
MLA_HEADS = 16
NOPE_DIM = 128
ROPE_DIM = 64
V_DIM = 128
Q_LORA = 1024
KV_LORA = 512
MLA_WIDTH = MLA_HEADS * V_DIM
MIX_WIDTH = FOX_WIDTH + MLA_WIDTH
ROPE_THETA = 10000.0
FORGET_BIAS_INIT = 3.0
EPS = 1e-6
IN_SIZES = (FOX_WIDTH, FOX_WIDTH, FOX_WIDTH, FOX_HEADS, FOX_WIDTH,
            Q_LORA, KV_LORA, ROPE_DIM, MLA_WIDTH)
N_IN = sum(IN_SIZES)
IN_OFFSETS = tuple(int(o) for o in np.cumsum(IN_SIZES)[:-1])
FOX_SCALE = 1.0 / math.sqrt(FOX_HEAD_DIM)
MLA_SCALE = 1.0 / math.sqrt(NOPE_DIM + ROPE_DIM)

kernel_name = "fox_mla_parallel_heads_stream_step"


def rmsnorm(x, g):
    xf = x.astype(jnp.float32)
    xf = xf * lax.rsqrt(jnp.mean(xf * xf, axis=-1, keepdims=True) + EPS)
    return (xf * g.astype(jnp.float32)).astype(x.dtype)


def rope(x, pos):
    half = x.shape[-1] // 2
    inv_freq = 1.0 / (ROPE_THETA ** (jnp.arange(half, dtype=jnp.float32) / half))
    ang = pos.astype(jnp.float32)[:, None] * inv_freq[None, :]
    shape = (1, pos.shape[0]) + (1,) * (x.ndim - 3) + (half,)
    cos = jnp.cos(ang).reshape(shape)
    sin = jnp.sin(ang).reshape(shape)
    xf = x.astype(jnp.float32)
    x1, x2 = xf[..., :half], xf[..., half:]
    return jnp.concatenate([x1 * cos - x2 * sin, x2 * cos + x1 * sin], axis=-1).astype(x.dtype)


def swept_attention(score_fn, q_inputs, q_pos, k_pos, v, per_frame):
    sq = q_pos.shape[0]
    blk = min(Q_BLOCK, sq)
    nb = sq // blk

    def split(a):
        return jnp.moveaxis(a.reshape((a.shape[0], nb, blk) + a.shape[2:]), 1, 0)

    xs = tuple(split(a) for a in q_inputs) + (q_pos.reshape(nb, blk),)

    def one(args):
        qi, pi = args[:-1], args[-1]
        s = score_fn(*qi)
        if per_frame:
            allowed = k_pos[None, :] <= pi[:, None]
        else:
            allowed = (k_pos[None, :] // CHUNK) <= (pi[:, None] // CHUNK)
        s = jnp.where(allowed[None, None], s, -jnp.inf)
        p = jax.nn.softmax(s, axis=-1).astype(v.dtype)
        return jnp.einsum('bhqk,bkhd->bqhd', p, v)

    out = lax.map(one, xs)
    out = jnp.moveaxis(out, 0, 1)
    return out.reshape((out.shape[0], sq) + out.shape[3:])


def mixer_layer(x, p, past):
    (g_norm, w_in, b_f, g_q_fox, g_k_fox, g_cq, w_qb, g_qn, g_qp,
     g_ckv, g_kp, w_kvb, g_kn, w_out) = p
    B, S, _ = x.shape
    past_len = 0 if past is None else past[0].shape[1]
    q_pos = past_len + jnp.arange(S, dtype=jnp.int32)
    k_pos = jnp.arange(past_len + S, dtype=jnp.int32)

    h = rmsnorm(x, g_norm)
    u = h @ w_in
    q_a, k_a, v_a, f_a, z_a, cq, ckv, kpe, z_b = jnp.split(u, IN_OFFSETS, axis=-1)

    q_f = rmsnorm(q_a.reshape(B, S, FOX_HEADS, FOX_HEAD_DIM), g_q_fox)
    k_f = rmsnorm(k_a.reshape(B, S, FOX_HEADS, FOX_HEAD_DIM), g_k_fox)
    v_f = v_a.reshape(B, S, FOX_HEADS, FOX_HEAD_DIM)
    logf = jax.nn.log_sigmoid(f_a.astype(jnp.float32) + b_f.astype(jnp.float32))
    if past is None:
        k_all, v_all, logf_all = k_f, v_f, logf
    else:
        k_all = jnp.concatenate([past[0].astype(k_f.dtype), k_f], axis=1)
        v_all = jnp.concatenate([past[1].astype(v_f.dtype), v_f], axis=1)
        logf_all = jnp.concatenate([past[2].astype(jnp.float32), logf], axis=1)
    cum = jnp.cumsum(logf_all, axis=1)
    f_q = cum[:, past_len:]
    f_k_t = jnp.swapaxes(cum, 1, 2)

    def fox_score(qi, fqi):
        s = jnp.einsum('bqhd,bkhd->bhqk', qi, k_all).astype(jnp.float32) * FOX_SCALE
        return s + jnp.swapaxes(fqi, 1, 2)[..., None] - f_k_t[:, :, None, :]

    o_a = swept_attention(fox_score, (q_f, f_q), q_pos, k_pos, v_all, per_frame=True)
    o_a = o_a.reshape(B, S, FOX_WIDTH) * jax.nn.silu(z_a)

    cq = rmsnorm(cq, g_cq)
    qb = (cq @ w_qb).reshape(B, S, MLA_HEADS, NOPE_DIM + ROPE_DIM)
    q_nope = rmsnorm(qb[..., :NOPE_DIM], g_qn)
    q_pe = rope(rmsnorm(qb[..., NOPE_DIM:], g_qp), q_pos)
    ckv = rmsnorm(ckv, g_ckv)
    kpe = rope(rmsnorm(kpe, g_kp), q_pos)
    if past is None:
        ckv_all, kpe_all = ckv, kpe
    else:
        ckv_all = jnp.concatenate([past[3].astype(ckv.dtype), ckv], axis=1)
        kpe_all = jnp.concatenate([past[4].astype(kpe.dtype), kpe], axis=1)
    sk = ckv_all.shape[1]
    kv = (ckv_all @ w_kvb).reshape(B, sk, MLA_HEADS, NOPE_DIM + V_DIM)
    k_nope = rmsnorm(kv[..., :NOPE_DIM], g_kn)
    v_b = kv[..., NOPE_DIM:]

    def mla_score(qn, qp):
        s = (jnp.einsum('bqhd,bkhd->bhqk', qn, k_nope)
             + jnp.einsum('bqhr,bkr->bhqk', qp, kpe_all))
        return s.astype(jnp.float32) * MLA_SCALE

    o_b = swept_attention(mla_score, (q_nope, q_pe), q_pos, k_pos, v_b, per_frame=False)
    o_b = o_b.reshape(B, S, MLA_WIDTH) * jax.nn.silu(z_b)

    y = x + jnp.concatenate([o_a, o_b], axis=-1) @ w_out
    return y, (k_f, v_f, logf, ckv, kpe)


def setup_inputs(seed: int = 0) -> dict:
    key = jax.random.key(seed)
    ks = jax.random.split(key, 24)
    f32 = jnp.float32

    def nrm(k, shape, scale=1.0):
        return jax.random.normal(k, shape, f32) * scale

    def gain(k, shape):
        return 1.0 + 0.05 * jax.random.normal(k, shape, f32)

    L = DEPTH
    return {
        "x_prompt": nrm(ks[0], (BATCH, SEQ, D_MODEL)),
        "x_sample": nrm(ks[1], (DEC_BATCH, DEC_SEQ, D_MODEL)),
        "cache_fox_k": nrm(ks[2], (L, DEC_BATCH, PAST_LEN, FOX_HEADS, FOX_HEAD_DIM)),
        "cache_fox_v": nrm(ks[3], (L, DEC_BATCH, PAST_LEN, FOX_HEADS, FOX_HEAD_DIM)),
        "cache_fox_logf": jax.nn.log_sigmoid(FORGET_BIAS_INIT + nrm(ks[4], (L, DEC_BATCH, PAST_LEN, FOX_HEADS))),
        "cache_mla_ckv": nrm(ks[5], (L, DEC_BATCH, PAST_LEN, KV_LORA)),
        "cache_mla_kpe": nrm(ks[6], (L, DEC_BATCH, PAST_LEN, ROPE_DIM)),
        "g_norm": gain(ks[7], (L, D_MODEL)),
        "w_in": nrm(ks[8], (L, D_MODEL, N_IN), D_MODEL ** -0.5),
        "b_f": FORGET_BIAS_INIT + 0.1 * jax.random.normal(ks[9], (L, FOX_HEADS), f32),
        "g_q_fox": gain(ks[10], (L, FOX_HEAD_DIM)),
        "g_k_fox": gain(ks[11], (L, FOX_HEAD_DIM)),
        "g_cq": gain(ks[12], (L, Q_LORA)),
        "w_qb": nrm(ks[13], (L, Q_LORA, MLA_HEADS * (NOPE_DIM + ROPE_DIM)), Q_LORA ** -0.5),
        "g_qn": gain(ks[14], (L, NOPE_DIM)),
        "g_qp": gain(ks[15], (L, ROPE_DIM)),
        "g_ckv": gain(ks[16], (L, KV_LORA)),
        "g_kp": gain(ks[17], (L, ROPE_DIM)),
        "w_kvb": nrm(ks[18], (L, KV_LORA, MLA_HEADS * (NOPE_DIM + V_DIM)), KV_LORA ** -0.5),
        "g_kn": gain(ks[19], (L, NOPE_DIM)),
        "w_out": nrm(ks[20], (L, MIX_WIDTH, D_MODEL), MIX_WIDTH ** -0.5),
    }


def reference(x_prompt, x_sample, cache_fox_k, cache_fox_v, cache_fox_logf, cache_mla_ckv,
              cache_mla_kpe, g_norm, w_in, b_f, g_q_fox, g_k_fox, g_cq, w_qb, g_qn, g_qp,
              g_ckv, g_kp, w_kvb, g_kn, w_out):
    y_p, y_s = x_prompt, x_sample
    rows_p, rows_s = [], []
    for l in range(DEPTH):
        p = (g_norm[l], w_in[l], b_f[l], g_q_fox[l], g_k_fox[l], g_cq[l], w_qb[l], g_qn[l],
             g_qp[l], g_ckv[l], g_kp[l], w_kvb[l], g_kn[l], w_out[l])
        y_p, r_p = mixer_layer(y_p, p, None)
        past = (cache_fox_k[l], cache_fox_v[l], cache_fox_logf[l], cache_mla_ckv[l], cache_mla_kpe[l])
        y_s, r_s = mixer_layer(y_s, p, past)
        rows_p.append(r_p)
        rows_s.append(r_s)

    def stk(rows, i):
        return jnp.stack([r[i] for r in rows], axis=0)

    return (y_p, y_s,
            stk(rows_p, 0), stk(rows_p, 1), stk(rows_p, 2), stk(rows_p, 3), stk(rows_p, 4),
            stk(rows_s, 0), stk(rows_s, 1), stk(rows_s, 2), stk(rows_s, 3), stk(rows_s, 4))
```

```cpp
#include <hip/hip_runtime.h>
#include <cstdio>
#include <cstdint>

#define GAS __attribute__((address_space(1)))
#define LAS __attribute__((address_space(3)))
typedef unsigned short bf16;
typedef short bf16x8 __attribute__((ext_vector_type(8)));
typedef short s16x4 __attribute__((ext_vector_type(4)));
typedef float f32x2 __attribute__((ext_vector_type(2)));
typedef float f32x4 __attribute__((ext_vector_type(4)));
typedef float f32x16 __attribute__((ext_vector_type(16)));
typedef unsigned u32x2 __attribute__((ext_vector_type(2)));
typedef unsigned u32x4 __attribute__((ext_vector_type(4)));

constexpr int DM = 4096, NBATCH = 4, SEQ = 2048, DEPTH = 2, DBATCH = 16, DSEQ = 16, PAST = 2048;
constexpr int MP = NBATCH * SEQ, MS = DBATCH * DSEQ, MA = MP + MS;
constexpr int FW = 2048, QL = 1024, KVL = 512, ROPE = 64, NIN = 11856;
constexpr int N1 = 11776;
constexpr int SKV = PAST + DSEQ;
constexpr int KVS_ROWS = DBATCH * SKV;
constexpr int CKVA_ROWS = MA + DBATCH * PAST;
#ifndef PADK
#define PADK 0
#endif
constexpr int HP = DM + PADK, WP = DM + PADK, OP = DM + PADK;
constexpr float EPS = 1e-6f;
constexpr float LOG2E = 1.4426950408889634f;
constexpr float FOX_C2 = 0.08838834764831845f * LOG2E;
constexpr float MLA_C2 = 0.07216878364870322f * LOG2E;

constexpr size_t MiB = 1u << 20;
constexpr size_t AL(size_t x) { return (x + 255) & ~(size_t)255; }
constexpr size_t WS_CTL = 0, CTL_BYTES = 2 * MiB;
constexpr size_t SZ_WIN = (size_t)N1 * WP * 2, SZ_W80 = (size_t)96 * DM * 2, SZ_WQB = (size_t)3072 * QL * 2, SZ_WKVB = (size_t)4096 * KVL * 2, SZ_WOUT = (size_t)DM * WP * 2;
constexpr size_t WS_WIN = CTL_BYTES;
constexpr size_t WS_W80 = WS_WIN + 2 * AL(SZ_WIN);
constexpr size_t WS_WQB = WS_W80 + 2 * AL(SZ_W80);
constexpr size_t WS_WKVB = WS_WQB + 2 * AL(SZ_WQB);
constexpr size_t WS_WOUT = WS_WKVB + 2 * AL(SZ_WKVB);
constexpr size_t WS_H = WS_WOUT + 2 * AL(SZ_WOUT);
constexpr size_t WS_QF = WS_H + AL((size_t)MA * HP * 2);
constexpr size_t WS_KF = WS_QF + AL((size_t)MA * FW * 2);
constexpr size_t WS_VF = WS_KF + AL((size_t)MA * FW * 2);
constexpr size_t WS_GATE = WS_VF + AL((size_t)MA * FW * 2);
constexpr size_t WS_CQG = WS_GATE + AL((size_t)MA * DM * 2);
constexpr size_t SZ_CKVA = (size_t)CKVA_ROWS * KVL * 2;
constexpr size_t WS_CKVA = WS_CQG + AL((size_t)MA * QL * 2);
constexpr size_t WS_QN = WS_CKVA + 2 * AL(SZ_CKVA);
constexpr size_t WS_KVP = WS_QN + AL((size_t)MA * 3072 * 2);
constexpr size_t WS_KVS = WS_KVP + AL((size_t)MP * 4096 * 2);
constexpr size_t WS_KPEP = WS_KVS + AL((size_t)(KVS_ROWS + 128) * 4096 * 2);
constexpr size_t SZ_KPES = (size_t)(KVS_ROWS + 128) * 64 * 2;
constexpr size_t WS_KPES = WS_KPEP + AL((size_t)MP * 64 * 2);
constexpr size_t WS_LOGF = WS_KPES + 2 * AL(SZ_KPES);
constexpr size_t WS_O = WS_LOGF + AL((size_t)MA * 16 * 4);
constexpr size_t WS_Y0 = WS_O + AL((size_t)MA * OP * 2);
constexpr size_t WS_ROPE = WS_Y0 + AL((size_t)MA * DM * 4);
constexpr size_t WS_SLAB = WS_ROPE + AL((size_t)SKV * 32 * 2 * 4);
constexpr size_t WS_END = WS_SLAB + (size_t)16 * MS * DM * 4;
constexpr int CW_BAR = 4096;
constexpr int CW_SSQH = 16384;
constexpr int CW_SSQCQ = CW_SSQH + 2 * MA;
constexpr int CW_SSQCKV = CW_SSQCQ + 2 * MA;
static_assert((CW_SSQCKV + 2 * MA) * 4 <= (int)CTL_BYTES, "ctl");
constexpr size_t O_YP = 0, O_YS = O_YP + (size_t)MP * DM, O_FKP = O_YS + (size_t)MS * DM, O_FVP = O_FKP + (size_t)2 * MP * FW, O_FLP = O_FVP + (size_t)2 * MP * FW,
                 O_CKVP = O_FLP + (size_t)2 * MP * 16, O_KPEP = O_CKVP + (size_t)2 * MP * KVL, O_FKS = O_KPEP + (size_t)2 * MP * ROPE, O_FVS = O_FKS + (size_t)2 * MS * FW,
                 O_FLS = O_FVS + (size_t)2 * MS * FW, O_CKVS = O_FLS + (size_t)2 * MS * 16, O_KPES = O_CKVS + (size_t)2 * MS * KVL, O_END = O_KPES + (size_t)2 * MS * ROPE;

constexpr int RING_BYTES = 131072;
constexpr int XCH_OFF = RING_BYTES;
constexpr int MISC_OFF = XCH_OFF + 16384;
constexpr int LDS_BYTES = MISC_OFF + 256;

struct Params {
    const float *x_p, *x_s, *c_fk, *c_fv, *c_fl, *c_ckv, *c_kpe, *g_norm, *w_in, *b_f, *g_qf, *g_kf, *g_cq, *w_qb, *g_qn, *g_qp, *g_ckv, *g_kp, *w_kvb, *g_kn, *w_out;
    float* out; unsigned char* ws; int lo, hi;
};

#define LDS_WAIT() asm volatile("s_waitcnt lgkmcnt(0)" ::: "memory")
#define VM_WAIT() asm volatile("s_waitcnt vmcnt(0)" ::: "memory")
#define SBAR() __builtin_amdgcn_sched_barrier(0)
__device__ __forceinline__ unsigned cvtpk(float lo, float hi) { unsigned r; asm volatile("v_cvt_pk_bf16_f32 %0, %1, %2" : "=v"(r) : "v"(lo), "v"(hi)); return r; }
__device__ __forceinline__ bf16x8 pack8(f32x4 a, f32x4 b) { u32x4 w = {cvtpk(a[0], a[1]), cvtpk(a[2], a[3]), cvtpk(b[0], b[1]), cvtpk(b[2], b[3])}; return __builtin_bit_cast(bf16x8, w); }
__device__ __forceinline__ float bf2f(unsigned short b) { return __uint_as_float(((unsigned)b) << 16); }
#define swz_xor(v, pat) __int_as_float(__builtin_amdgcn_ds_swizzle(__float_as_int(v), pat))
#define SWZ_X1 0x041F
#define SWZ_X2 0x081F
#define SWZ_X4 0x101F
#define SWZ_X8 0x201F
#define SWZ_X16 0x401F
__device__ __forceinline__ float xor16(float v) { return __int_as_float(__builtin_amdgcn_ds_swizzle(__float_as_int(v), SWZ_X16)); }
__device__ __forceinline__ float sum32(float v) { auto r = __builtin_amdgcn_permlane32_swap(__float_as_uint(v), __float_as_uint(v), false, false); return __uint_as_float(r[0]) + __uint_as_float(r[1]); }
__device__ __forceinline__ float max32(float v) { auto r = __builtin_amdgcn_permlane32_swap(__float_as_uint(v), __float_as_uint(v), false, false); return fmaxf(__uint_as_float(r[0]), __uint_as_float(r[1])); }
__device__ __forceinline__ float wave_sum(float v) {
    v += __int_as_float(__builtin_amdgcn_ds_swizzle(__float_as_int(v), SWZ_X1)); v += __int_as_float(__builtin_amdgcn_ds_swizzle(__float_as_int(v), SWZ_X2));
    v += __int_as_float(__builtin_amdgcn_ds_swizzle(__float_as_int(v), SWZ_X4)); v += __int_as_float(__builtin_amdgcn_ds_swizzle(__float_as_int(v), SWZ_X8));
    v += xor16(v); return sum32(v);
}
__device__ __forceinline__ int opaque_tid() { int t = threadIdx.x; asm volatile("" : "+v"(t)); return t; }
template <class T> __device__ __forceinline__ T* opaque_ptr(T* p) { asm volatile("" : "+s"(p)); return (T*)(GAS T*)p; }
__device__ __forceinline__ float silu_f(float v) { return v * __builtin_amdgcn_rcpf(1.0f + __expf(-v)); }
__device__ __forceinline__ void atomic_addf(float* p, float v) { (void)__hip_atomic_fetch_add((GAS float*)p, v, __ATOMIC_RELAXED, __HIP_MEMORY_SCOPE_AGENT); }

#define XB_TMO      128
#define XB_XCNT(j)  (256  + 64 * (j))
#define XB_XSUB(j)  (1280 + 64 * (j))
#define XB_XGEN(j)  (2304 + 64 * (j))
#define XB_TOP      3328
#define XB_TOPGEN   3392
#define XCD_BAR_WORDS 3456
#define XB_SPIN_CAP (1u << 20)
__device__ __forceinline__ unsigned xb_ld(unsigned* p)              { return __hip_atomic_load(p, __ATOMIC_RELAXED, __HIP_MEMORY_SCOPE_AGENT); }
__device__ __forceinline__ unsigned xb_add(unsigned* p, unsigned v) { return __hip_atomic_fetch_add(p, v, __ATOMIC_RELAXED, __HIP_MEMORY_SCOPE_AGENT); }
__device__ __forceinline__ unsigned xb_xcc_id() { return (unsigned)__builtin_amdgcn_s_getreg((3 << 11) | 20) & 0xFu; }
#define XB_SPIN(cond, bar) do { unsigned _sp = 0; while (cond) { __builtin_amdgcn_s_sleep(1); \
    if ((++_sp & 255u) == 0u) { if (xb_ld(&(bar)[XB_TMO])) break; if (_sp > XB_SPIN_CAP) { atomicAdd(&(bar)[XB_TMO], 1u); break; } } } } while (0)
__device__ __forceinline__ void xcd_barrier_post(unsigned* bar) { if (threadIdx.x == 0) (void)xb_add(&bar[XB_XCNT(xb_xcc_id())], 1u); }
__device__ __forceinline__ void xcd_barrier_census(unsigned* bar, volatile LAS unsigned* st) {
    const unsigned G = gridDim.x * gridDim.y * gridDim.z; const unsigned x = xb_xcc_id(); const int lane = (int)threadIdx.x;
    unsigned sum, cnt, mine, sp = 0u;
    for (;;) {
        const unsigned c = lane < 16 ? xb_ld(&bar[XB_XCNT(lane)]) : 0u;
        int t = (int)c;
        t += __builtin_amdgcn_ds_swizzle(t, SWZ_X8); t += __builtin_amdgcn_ds_swizzle(t, SWZ_X4); t += __builtin_amdgcn_ds_swizzle(t, SWZ_X2); t += __builtin_amdgcn_ds_swizzle(t, SWZ_X1);
        sum = (unsigned)__builtin_amdgcn_readfirstlane(t);
        cnt = (unsigned)__builtin_popcountll(__ballot(c > 0u)); mine = (unsigned)__builtin_amdgcn_readlane((int)c, (int)x);
        if (sum == G) break;
        __builtin_amdgcn_s_sleep(1);
        if ((++sp & 255u) == 0u) { if (xb_ld(&bar[XB_TMO])) break; if (sp > XB_SPIN_CAP) { if (lane == 0) atomicAdd(&bar[XB_TMO], 1u); break; } }
    }
    if (lane == 0) { st[0] = mine > 0u ? mine : 1u; st[1] = cnt > 0u ? cnt : 1u; }
}
__device__ __forceinline__ void xcd_barrier(unsigned* bar, volatile LAS unsigned* st) {
    asm volatile("s_waitcnt vmcnt(0)" ::: "memory");
    __syncthreads();
    if (threadIdx.x < 64) {
        if (st[0] == 0u) xcd_barrier_census(bar, st);
        asm volatile("s_waitcnt lgkmcnt(0)" ::: "memory");
    }
    if (threadIdx.x == 0) {
        const unsigned x = xb_xcc_id();
        __builtin_amdgcn_s_waitcnt(0);
        const unsigned nloc = st[0], nx = st[1];
        const unsigned old = xb_add(&bar[XB_XSUB(x)], 1u);
        const unsigned gen = old / nloc;
        if (old + 1u == (gen + 1u) * nloc) {
            __builtin_amdgcn_fence(__ATOMIC_RELEASE, "agent");
            asm volatile("s_waitcnt vmcnt(0)" ::: "memory");
            const unsigned og = xb_add(&bar[XB_TOP], 1u);
            const unsigned tg = og / nx;
            if (og + 1u == (tg + 1u) * nx) xb_add(&bar[XB_TOPGEN], 1u);
            else XB_SPIN(xb_ld(&bar[XB_TOPGEN]) == tg, bar);
            __builtin_amdgcn_fence(__ATOMIC_ACQUIRE, "agent");
            xb_add(&bar[XB_XGEN(x)], 1u);
            asm volatile("s_waitcnt vmcnt(0)" ::: "memory");
        } else {
            XB_SPIN(xb_ld(&bar[XB_XGEN(x)]) == gen, bar);
            __builtin_amdgcn_fence(__ATOMIC_ACQUIRE, "agent");
            asm volatile("s_waitcnt vmcnt(0)" ::: "memory");
        }
    }
    __syncthreads();
}

namespace pg8 {
constexpr int BM = 256, BK = 64, HALF = 128, HTB = HALF * BK * 2, STAGE_BYTES = 8 * HTB, NXCD = 8, WG1 = 105, WG2 = 105, WG2C = 108, WG3 = 105;
__host__ __device__ __forceinline__ int lds_byte(int r, int c) { const int st = (r >> 4) * 2 + (c >> 5), rr = r & 15, cc = c & 31, ob = rr * 64 + cc * 2; return st * 1024 + (ob ^ (((ob >> 9) & 1) << 5)); }
__host__ __device__ __forceinline__ void stage_rc(int b, int& R, int& C) { const int st = b / 1024, sb = b % 1024, swz = sb ^ (((sb >> 9) & 1) << 5); R = (st >> 1) * 16 + swz / 64; C = (st & 1) * 32 + (swz % 64) / 2; }
__host__ __device__ __forceinline__ int perm32(int rho) { const int n = rho >> 4, i = rho & 15; return 8 * (i >> 2) + 4 * n + (i & 3); }
struct Unit { int pm, pn, ko; };
template <int NM, int NN, int BASE, int SPLITS, int K, int WGM>
struct Order {
    int G, c, i0;
    __device__ __forceinline__ void init(int G_, int c_) { G = G_; c = c_; i0 = BASE <= c_ ? 0 : (BASE - c_ + G_ - 1) / G_; }
    __device__ __forceinline__ bool next(int i, Unit& u) const {
        constexpr int nwg = NM * NN * SPLITS;
        const int L = (i0 + i) * G + c - BASE; if (L >= nwg) return false;
        if constexpr (SPLITS > 1) { u.pm = 0; u.pn = L % NN; u.ko = (L / NN) * K; }
        else { int wgid = L; { constexpr int q = nwg / NXCD, r = nwg % NXCD; const int xcd = wgid % NXCD, off = wgid / NXCD; wgid = (xcd < r ? xcd * (q + 1) : r * (q + 1) + (xcd - r) * q) + off; }
            constexpr int WG = WGM % 100; constexpr bool ROT = WGM >= 100;
            constexpr int nig = WG * NN; const int gid = wgid / nig, fm = gid * WG, gsz = (NM - fm) < WG ? (NM - fm) : WG;
            u.pm = fm + ((wgid % nig) % gsz); u.pn = (wgid % nig) / gsz; u.ko = 0;
            if constexpr (ROT) { u.pn += (((fm * 8) / NM) * NN) / 8; if (u.pn >= NN) u.pn -= NN; } }
        return true;
    }
};

typedef f32x4 Acc[2][2][4][2];

template <int M, int N, int K, int LDA, int LDB, int BASE, int SPLITS, int WGM, class Epi>
__device__ __forceinline__ void gemm_phase(LAS unsigned char* lds, const bf16* gA, const bf16* gBt, const Epi& E) {
    int g_ = (int)gridDim.x, c_ = (int)blockIdx.x; asm volatile("" : "+s"(g_), "+s"(c_));
    Order<M / BM, N / BM, BASE, SPLITS, K, WGM> S; S.init(g_, c_);
    int tid_ = threadIdx.x; asm volatile("" : "+v"(tid_));
    const int tid = tid_, wid = __builtin_amdgcn_readfirstlane(tid >> 6), lane = tid & 63, wr = wid >> 2, wc = wid & 3, fr = lane & 15, fq = lane >> 4;
    constexpr int nt = K / BK;
    unsigned voffA[2], voffB[2];
#pragma unroll
    for (int i = 0; i < 2; ++i) { int R, C; stage_rc(tid * 16 + i * 8192, R, C); const int Rb = (R & ~31) + perm32(R & 31);
        voffA[i] = (unsigned)(R * LDA + C) * 2u; voffB[i] = (unsigned)(Rb * LDB + C) * 2u; }
    constexpr size_t kstep = (size_t)(BK * 2);
    constexpr size_t hstepA = (size_t)HALF * LDA * 2, hstepB = (size_t)HALF * LDB * 2;
    constexpr size_t tstepA = 2 * hstepA, tstepB = 2 * hstepB;
    const unsigned ldsw = (unsigned)wid * 1024u;
    const int aoff = lds_byte(wr * 64 + fr, fq * 8), boff = lds_byte(wc * 32 + fr, fq * 8);
#define PG8_SA(b, h) (((b) * 2 + (h)) * HTB)
#define PG8_SB(b, h) ((4 + (b) * 2 + (h)) * HTB)
#define PG8_STAGE(bufoff, gbase, voff) do { _Pragma("unroll") for (int _i = 0; _i < 2; ++_i) \
        __builtin_amdgcn_global_load_lds((const unsigned*)((const char*)(gbase) + (voff)[_i]), (LAS unsigned*)(lds + (bufoff) + ldsw + _i * 8192), 16, 0, 1); } while (0)
#define PG8_LDA(dst, b, h) do { _Pragma("unroll") for (int m = 0; m < 4; ++m) _Pragma("unroll") for (int k = 0; k < 2; ++k) dst[m][k] = *(const LAS bf16x8*)(lds + PG8_SA(b, h) + aoff + m * 2048 + k * 1024); } while (0)
#define PG8_LDB(dst, b, h) do { _Pragma("unroll") for (int n = 0; n < 2; ++n) _Pragma("unroll") for (int k = 0; k < 2; ++k) dst[n][k] = *(const LAS bf16x8*)(lds + PG8_SB(b, h) + boff + n * 2048 + k * 1024); } while (0)
#define PG8_MMA(ai, bj, At, Bt) do { __builtin_amdgcn_s_setprio(1); _Pragma("unroll") for (int m = 0; m < 4; ++m) _Pragma("unroll") for (int n = 0; n < 2; ++n) _Pragma("unroll") for (int k = 0; k < 2; ++k) \
        acc[ai][bj][m][n] = __builtin_amdgcn_mfma_f32_16x16x32_bf16(Bt[n][k], At[m][k], acc[ai][bj][m][n], 0, 0, 0); __builtin_amdgcn_s_setprio(0); } while (0)
#define PG8_WAIT_V(n) asm volatile("s_waitcnt vmcnt(" #n ")" ::: "memory")
#define PG8_WAIT_L(n) asm volatile("s_waitcnt lgkmcnt(" #n ")" ::: "memory")
#define PG8_BAR __builtin_amdgcn_s_barrier()
#define PG8_SCHED __builtin_amdgcn_sched_barrier(0)
    Unit cur, nxt; int ui = 0;
    if (!S.next(0, cur)) return;
    Acc acc;
#pragma unroll
    for (int a = 0; a < 2; ++a)
#pragma unroll
        for (int b = 0; b < 2; ++b)
#pragma unroll
            for (int m = 0; m < 4; ++m)
#pragma unroll
                for (int n = 0; n < 2; ++n) acc[a][b][m][n] = (f32x4){0.f, 0.f, 0.f, 0.f};
    bf16x8 At[4][2], B0[2][2], B1[2][2];
    const char* cA = (const char*)gA + (size_t)cur.pm * tstepA + (size_t)cur.ko * 2; const char* cB = (const char*)gBt + (size_t)cur.pn * tstepB + (size_t)cur.ko * 2;
    PG8_STAGE(PG8_SB(0, 0), cB, voffB); PG8_STAGE(PG8_SB(0, 1), cB + hstepB, voffB); PG8_STAGE(PG8_SA(0, 0), cA, voffA); PG8_STAGE(PG8_SA(0, 1), cA + hstepA, voffA);
    if (wr == 1) PG8_BAR;
    PG8_WAIT_V(2); PG8_BAR;
    PG8_STAGE(PG8_SB(1, 0), cB + kstep, voffB); PG8_STAGE(PG8_SA(1, 0), cA + kstep, voffA); PG8_STAGE(PG8_SB(1, 1), cB + hstepB + kstep, voffB);
    PG8_WAIT_V(6); PG8_BAR;
    for (;;) {
        const bool has_next = S.next(ui + 1, nxt);
        const char* nA = has_next ? (const char*)gA + (size_t)nxt.pm * tstepA + (size_t)nxt.ko * 2 : cA; const char* nB = has_next ? (const char*)gBt + (size_t)nxt.pn * tstepB + (size_t)nxt.ko * 2 : cB;
        for (int t = 0; t < nt; t += 2) {
            const bool last = (t == nt - 2);
            const char* a1 = cA + (size_t)(t + 1) * kstep;
            const char* a2 = last ? nA : cA + (size_t)(t + 2) * kstep; const char* b2 = last ? nB : cB + (size_t)(t + 2) * kstep;
            const char* a3 = a2 + kstep; const char* b3 = b2 + kstep;
            asm volatile("" : "+s"(a1), "+s"(a2), "+s"(b2), "+s"(a3), "+s"(b3));
            PG8_LDB(B0, 0, 0); PG8_LDB(B1, 0, 1); PG8_SCHED; PG8_LDA(At, 0, 0); PG8_STAGE(PG8_SA(1, 1), a1 + hstepA, voffA);
            PG8_WAIT_V(8); PG8_WAIT_L(0); PG8_BAR; PG8_MMA(0, 0, At, B0); PG8_MMA(0, 1, At, B1); PG8_BAR; PG8_SCHED;
            PG8_LDA(At, 0, 1); PG8_STAGE(PG8_SB(0, 0), b2, voffB); PG8_STAGE(PG8_SB(0, 1), b2 + hstepB, voffB); PG8_STAGE(PG8_SA(0, 0), a2, voffA);
            PG8_WAIT_V(8); PG8_WAIT_L(0); PG8_BAR; PG8_MMA(1, 0, At, B0); PG8_MMA(1, 1, At, B1); PG8_BAR; PG8_SCHED;
            PG8_LDB(B0, 1, 0); PG8_LDB(B1, 1, 1); PG8_SCHED; PG8_LDA(At, 1, 0); PG8_STAGE(PG8_SA(0, 1), a2 + hstepA, voffA);
            PG8_WAIT_V(8); PG8_WAIT_L(0); PG8_BAR; PG8_MMA(0, 0, At, B0); PG8_MMA(0, 1, At, B1); PG8_BAR; PG8_SCHED;
            PG8_LDA(At, 1, 1); PG8_STAGE(PG8_SB(1, 0), b3, voffB); PG8_STAGE(PG8_SB(1, 1), b3 + hstepB, voffB); PG8_STAGE(PG8_SA(1, 0), a3, voffA);
            PG8_WAIT_V(8); PG8_WAIT_L(0); PG8_BAR; PG8_MMA(1, 0, At, B0); PG8_MMA(1, 1, At, B1); PG8_BAR; PG8_SCHED;
        }
        if constexpr (Epi::SYNC) { if (wr == 0) PG8_BAR; }
        { const int t2 = opaque_tid();
          E(acc, cur, wr, wc, t2 & 15, (t2 >> 4) & 3, ui); }
        if (!has_next) break;
#pragma unroll
        for (int a = 0; a < 2; ++a)
#pragma unroll
            for (int b = 0; b < 2; ++b)
#pragma unroll
                for (int m = 0; m < 4; ++m)
#pragma unroll
                    for (int n = 0; n < 2; ++n) acc[a][b][m][n] = (f32x4){0.f, 0.f, 0.f, 0.f};
        cur = nxt; cA = nA; cB = nB; ++ui;
        if constexpr (Epi::SYNC) { if (wr == 1) PG8_BAR; }
    }
    PG8_WAIT_V(0);
    if constexpr (!Epi::SYNC) { if (wr == 0) PG8_BAR; }
    PG8_BAR;
#undef PG8_SA
#undef PG8_SB
#undef PG8_STAGE
#undef PG8_LDA
#undef PG8_LDB
#undef PG8_MMA
#undef PG8_WAIT_V
#undef PG8_WAIT_L
#undef PG8_BAR
#undef PG8_SCHED
}

#define FOR_AM _Pragma("unroll") for (int ai = 0; ai < 2; ++ai) _Pragma("unroll") for (int m = 0; m < 4; ++m)
#define FOR_BN _Pragma("unroll") for (int bj = 0; bj < 2; ++bj) _Pragma("unroll") for (int n = 0; n < 2; ++n)
__device__ __forceinline__ void part_ss(const Acc& acc, float (&ss)[2][4][2]) {
    FOR_AM {
#pragma unroll
        for (int bj = 0; bj < 2; ++bj) { const f32x4 a = acc[ai][bj][m][0], b = acc[ai][bj][m][1];
            float s = (a[0] * a[0] + a[1] * a[1]) + (a[2] * a[2] + a[3] * a[3]) + (b[0] * b[0] + b[1] * b[1]) + (b[2] * b[2] + b[3] * b[3]);
            s += xor16(s); s = sum32(s); ss[ai][m][bj] = s; } }
}
__device__ __forceinline__ void xchg_ss(const float (&ss)[2][4][2], LAS float* X, int wr, int wc, int fr, int fq) {
    if (fq == 0) { FOR_AM {
#pragma unroll
        for (int bj = 0; bj < 2; ++bj) X[((ai * 128 + wr * 64 + m * 16 + fr) * 2 + bj) * 4 + wc] = ss[ai][m][bj]; } }
    asm volatile("s_waitcnt lgkmcnt(0)" ::: "memory"); __builtin_amdgcn_s_barrier(); asm volatile("" ::: "memory");
}
__device__ __forceinline__ f32x4 xrd(const LAS float* X, int rloc, int bj) { return *(const LAS f32x4*)(X + (rloc * 2 + bj) * 4); }
__device__ __forceinline__ void row_scale(Acc& acc, const float* ssq, float invk, int row0) {
    FOR_AM { const float rs = rsqrtf(((const GAS float*)ssq)[row0 + ai * 128 + m * 16] * invk + EPS);
        FOR_BN acc[ai][bj][m][n] *= rs; }
}
__device__ __forceinline__ u32x4 pk8(const f32x4 a, const f32x4 b) { u32x4 w = {cvtpk(a[0], a[1]), cvtpk(a[2], a[3]), cvtpk(b[0], b[1]), cvtpk(b[2], b[3])}; return w; }
template <bool NT = false>
__device__ __forceinline__ void store_bf16(const Acc& acc, bf16* base, size_t pitch, int row0, int col0) {
    FOR_AM { bf16* rp = base + (size_t)(row0 + ai * 128 + m * 16) * pitch + col0;
#pragma unroll
        for (int bj = 0; bj < 2; ++bj) { const u32x4 w_ = pk8(acc[ai][bj][m][0], acc[ai][bj][m][1]);
            if (NT) __builtin_nontemporal_store(w_, (GAS u32x4*)(rp + bj * 128)); else *(GAS u32x4*)(rp + bj * 128) = w_; }
        asm volatile("" ::: "memory"); }
}
template <bool NT = false>
__device__ __forceinline__ void store_f32(const Acc& acc, float* base, size_t pitch, int row0, int col0) {
    FOR_AM { float* rp = base + (size_t)(row0 + ai * 128 + m * 16) * pitch + col0;
#pragma unroll
        for (int bj = 0; bj < 2; ++bj) {
            if (NT) { __builtin_nontemporal_store(acc[ai][bj][m][0], (GAS f32x4*)(rp + bj * 128)); __builtin_nontemporal_store(acc[ai][bj][m][1], (GAS f32x4*)(rp + bj * 128 + 4)); }
            else { *(GAS f32x4*)(rp + bj * 128) = acc[ai][bj][m][0]; *(GAS f32x4*)(rp + bj * 128 + 4) = acc[ai][bj][m][1]; } }
        asm volatile("" ::: "memory"); }
}

struct Epi1qk {
    static constexpr bool SYNC = true;
    const Params& P; int l; LAS float* X;
    __device__ __forceinline__ void operator()(Acc& acc, const Unit& u, int wr, int wc, int fr, int fq, int ui) const {
        unsigned char* ws = opaque_ptr(P.ws); float* ctl = (float*)(ws + WS_CTL);
        const int pn = u.pn, row0 = u.pm * BM + wr * 64 + fr, cl = wc * 32 + 8 * fq;
        const bool smp = u.pm >= MP / BM; const int rowo = smp ? row0 - MP : row0;
        row_scale(acc, ctl + CW_SSQH + l * MA, 1.0f / DM, row0);
        { float ss[2][4][2]; part_ss(acc, ss); xchg_ss(ss, X + (ui & 1) * 2048, wr, wc, fr, fq); }
        const bool isk = pn >= 8; const int colh = (pn & 7) * 256 + cl;
        const float* gp = (isk ? P.g_kf : P.g_qf) + l * 128 + cl; const f32x4 g0 = *(const GAS f32x4*)gp, g1 = *(const GAS f32x4*)(gp + 4);
        bf16* bb = (bf16*)(ws + (isk ? WS_KF : WS_QF)); float* fo = P.out + (smp ? O_FKS + (size_t)l * MS * FW : O_FKP + (size_t)l * MP * FW);
        FOR_AM { const int rloc = ai * 128 + wr * 64 + m * 16 + fr;
#pragma unroll
            for (int bj = 0; bj < 2; ++bj) { const f32x4 t = xrd(X + (ui & 1) * 2048, rloc, bj); const float rn = rsqrtf(((t[0] + t[1]) + (t[2] + t[3])) * (1.0f / 128) + EPS);
                const f32x4 a = acc[ai][bj][m][0] * rn * g0, b = acc[ai][bj][m][1] * rn * g1;
                __builtin_nontemporal_store(pk8(a, b), (GAS u32x4*)(bb + (size_t)(row0 + ai * 128 + m * 16) * FW + colh + bj * 128));
                if (isk) { float* rp = fo + (size_t)(rowo + ai * 128 + m * 16) * FW + colh + bj * 128; __builtin_nontemporal_store(a, (GAS f32x4*)rp); __builtin_nontemporal_store(b, (GAS f32x4*)(rp + 4)); } }
            asm volatile("" ::: "memory"); }
    }
};
struct Epi1vg {
    static constexpr bool SYNC = false;
    const Params& P; int l;
    __device__ __forceinline__ void operator()(Acc& acc, const Unit& u, int wr, int wc, int fr, int fq, int ui) const {
        unsigned char* ws = opaque_ptr(P.ws);
        const int pn = u.pn, row0 = u.pm * BM + wr * 64 + fr, cl = wc * 32 + 8 * fq;
        row_scale(acc, (const float*)(ws + WS_CTL) + CW_SSQH + l * MA, 1.0f / DM, row0);
        if (pn < 8) {
            const bool smp = u.pm >= MP / BM; const int rowo = smp ? row0 - MP : row0; const int colh = pn * 256 + cl;
            store_bf16<true>(acc, (bf16*)(ws + WS_VF), FW, row0, colh); store_f32<true>(acc, P.out + (smp ? O_FVS + (size_t)l * MS * FW : O_FVP + (size_t)l * MP * FW), FW, rowo, colh);
        } else {
            FOR_AM { FOR_BN {
#pragma unroll
                for (int e = 0; e < 4; ++e) acc[ai][bj][m][n][e] = silu_f(acc[ai][bj][m][n][e]); } }
            store_bf16<true>(acc, (bf16*)(ws + WS_GATE), DM, row0, (pn - 8) * 256 + cl);
        }
    }
};
struct Epi1c {
    static constexpr bool SYNC = false;
    const Params& P; int l;
    __device__ __forceinline__ void operator()(Acc& acc, const Unit& u, int wr, int wc, int fr, int fq, int ui) const {
        unsigned char* ws = opaque_ptr(P.ws); float* ctl = (float*)(ws + WS_CTL);
        const int pn = u.pn, row0 = u.pm * BM + wr * 64 + fr, cl = wc * 32 + 8 * fq;
        const bool smp = u.pm >= MP / BM; const int rowo = smp ? row0 - MP : row0;
        row_scale(acc, ctl + CW_SSQH + l * MA, 1.0f / DM, row0);
        const bool isc = pn >= 4;
        { float ss[2][4][2]; part_ss(acc, ss); float* sq = ctl + (isc ? CW_SSQCKV : CW_SSQCQ) + l * MA;
          if (fq == 0) { FOR_AM atomic_addf(sq + row0 + ai * 128 + m * 16, ss[ai][m][0] + ss[ai][m][1]); } }
        const int colc = (isc ? (pn - 4) : pn) * 256 + cl;
        const float* gp = (isc ? P.g_ckv + l * KVL : P.g_cq + l * QL) + colc;
#pragma unroll
        for (int bj = 0; bj < 2; ++bj) { const f32x4 g0 = *(const GAS f32x4*)(gp + bj * 128), g1 = *(const GAS f32x4*)(gp + bj * 128 + 4);
            FOR_AM { acc[ai][bj][m][0] *= g0; acc[ai][bj][m][1] *= g1; } }
        if (isc) { store_bf16(acc, (bf16*)(ws + WS_CKVA + l * AL(SZ_CKVA)), KVL, row0, colc); store_f32(acc, P.out + (smp ? O_CKVS + (size_t)l * MS * KVL : O_CKVP + (size_t)l * MP * KVL), KVL, rowo, colc); }
        else store_bf16(acc, (bf16*)(ws + WS_CQG), QL, row0, colc);
    }
};

struct Epi2a {
    static constexpr bool SYNC = true;
    const Params& P; int l; LAS float* X;
    __device__ __forceinline__ void operator()(Acc& acc, const Unit& u, int wr, int wc, int fr, int fq, int ui) const {
        unsigned char* ws = opaque_ptr(P.ws); bf16* QN = (bf16*)(ws + WS_QN);
        const int pn = u.pn, row0 = u.pm * BM + wr * 64 + fr, cl = wc * 32 + 8 * fq;
        row_scale(acc, (const float*)(ws + WS_CTL) + CW_SSQCQ + l * MA, 1.0f / QL, row0);
        { float ss[2][4][2]; part_ss(acc, ss); xchg_ss(ss, X + (ui & 1) * 2048, wr, wc, fr, fq); }
        const LAS float* Xr = X + (ui & 1) * 2048;
        if (pn < 8) {
            const float* gp = P.g_qn + l * 128 + cl; const f32x4 g0 = *(const GAS f32x4*)gp, g1 = *(const GAS f32x4*)(gp + 4);
            FOR_AM { const int rloc = ai * 128 + wr * 64 + m * 16 + fr; bf16* rp = QN + (size_t)(row0 + ai * 128 + m * 16) * 3072 + 192 * (2 * pn) + cl;
#pragma unroll
                for (int bj = 0; bj < 2; ++bj) { const f32x4 t = xrd(Xr, rloc, bj); const float rn = rsqrtf(((t[0] + t[1]) + (t[2] + t[3])) * (1.0f / 128) + EPS);
                    *(GAS u32x4*)(rp + 192 * bj) = pk8(acc[ai][bj][m][0] * rn * g0, acc[ai][bj][m][1] * rn * g1); }
                asm volatile("" ::: "memory"); }
        } else {
            const int i0 = 16 * (wc & 1) + 4 * fq;
            const f32x4 ga = *(const GAS f32x4*)(P.g_qp + l * 64 + i0), gb = *(const GAS f32x4*)(P.g_qp + l * 64 + 32 + i0);
            const float* rope = (const float*)(ws + WS_ROPE);
            f32x4 cs[2][4][2];
            FOR_AM { const int row = row0 + ai * 128 + m * 16; const int pos = row < MP ? (row & (SEQ - 1)) : PAST + ((row - MP) & (DSEQ - 1));
                cs[ai][m][0] = *(const GAS f32x4*)(rope + ((size_t)pos * 32 + i0) * 2); cs[ai][m][1] = *(const GAS f32x4*)(rope + ((size_t)pos * 32 + i0) * 2 + 4); }
            FOR_AM { const int rloc = ai * 128 + wr * 64 + m * 16 + fr; const int row = row0 + ai * 128 + m * 16;
                const f32x4 cs0 = cs[ai][m][0], cs1 = cs[ai][m][1];
#pragma unroll
                for (int bj = 0; bj < 2; ++bj) { const f32x4 t = xrd(Xr, rloc, bj); const float rn = rsqrtf(((wc & 2) ? (t[2] + t[3]) : (t[0] + t[1])) * (1.0f / 64) + EPS);
                    const f32x4 a = acc[ai][bj][m][0] * rn, b = acc[ai][bj][m][1] * rn;
                    const float x10 = a[0] * ga[0], x20 = a[1] * gb[0], x11 = a[2] * ga[1], x21 = a[3] * gb[1], x12 = b[0] * ga[2], x22 = b[1] * gb[2], x13 = b[2] * ga[3], x23 = b[3] * gb[3];
                    const float o10 = x10 * cs0[0] - x20 * cs0[1], o20 = x20 * cs0[0] + x10 * cs0[1], o11 = x11 * cs0[2] - x21 * cs0[3], o21 = x21 * cs0[2] + x11 * cs0[3];
                    const float o12 = x12 * cs1[0] - x22 * cs1[1], o22 = x22 * cs1[0] + x12 * cs1[1], o13 = x13 * cs1[2] - x23 * cs1[3], o23 = x23 * cs1[2] + x13 * cs1[3];
                    const int head = 4 * (pn - 8) + 2 * bj + (wc >> 1);
                    bf16* rp = QN + (size_t)row * 3072 + 192 * head + 128 + i0;
                    u32x2 w1 = {cvtpk(o10, o11), cvtpk(o12, o13)}, w2 = {cvtpk(o20, o21), cvtpk(o22, o23)};
                    *(GAS u32x2*)rp = w1; *(GAS u32x2*)(rp + 32) = w2; }
                asm volatile("" ::: "memory"); }
        }
    }
};

struct Epi2k {
    static constexpr bool SYNC = true;
    const Params& P; int l; LAS float* X;
    __device__ __forceinline__ void operator()(Acc& acc, const Unit& u, int wr, int wc, int fr, int fq, int ui) const {
        unsigned char* ws = opaque_ptr(P.ws);
        const int row0 = u.pm * BM + wr * 64 + fr, cl = wc * 32 + 8 * fq;
        row_scale(acc, (const float*)(ws + WS_CTL) + CW_SSQCKV + l * MA, 1.0f / KVL, row0);
        { float ss[2][4][2]; part_ss(acc, ss); xchg_ss(ss, X + (ui & 1) * 2048, wr, wc, fr, fq); }
        const LAS float* Xr = X + (ui & 1) * 2048;
        const f32x4 g0 = *(const GAS f32x4*)(P.g_kn + l * 128 + cl), g1 = *(const GAS f32x4*)(P.g_kn + l * 128 + cl + 4);
        FOR_AM { const int rloc = ai * 128 + wr * 64 + m * 16 + fr; const int row = row0 + ai * 128 + m * 16; size_t drow;
            if (u.pm < MP / BM) drow = (size_t)(WS_KVP / 2) + (size_t)row * 4096;
            else { const int r = row - MP; drow = (size_t)(WS_KVS / 2) + (size_t)((r >> 4) * SKV + PAST + (r & 15)) * 4096; }
            bf16* rp = (bf16*)ws + drow + u.pn * 256 + cl;
            const f32x4 t = xrd(Xr, rloc, 0); const float rn = rsqrtf(((t[0] + t[1]) + (t[2] + t[3])) * (1.0f / 128) + EPS);
            *(GAS u32x4*)rp = pk8(acc[ai][0][m][0] * rn * g0, acc[ai][0][m][1] * rn * g1); *(GAS u32x4*)(rp + 128) = pk8(acc[ai][1][m][0], acc[ai][1][m][1]);
            asm volatile("" ::: "memory"); }
    }
};
struct Epi2c {
    static constexpr bool SYNC = false;
    const Params& P; int l;
    __device__ __forceinline__ void operator()(Acc& acc, const Unit& u, int wr, int wc, int fr, int fq, int ui) const {
        unsigned char* ws = opaque_ptr(P.ws);
        const int row0 = u.pm * BM + wr * 64 + fr, cl = wc * 32 + 8 * fq;
        FOR_AM { const int c = row0 + ai * 128 + m * 16;
            bf16* rp = (bf16*)(ws + WS_KVS) + (size_t)((c >> 11) * SKV + (c & (PAST - 1))) * 4096 + u.pn * 256 + cl;
            __builtin_nontemporal_store(pk8(acc[ai][0][m][0], acc[ai][0][m][1]), (GAS u32x4*)rp); __builtin_nontemporal_store(pk8(acc[ai][1][m][0], acc[ai][1][m][1]), (GAS u32x4*)(rp + 128));
            asm volatile("" ::: "memory"); }
    }
};

struct Epi3 {
    static constexpr bool SYNC = false;
    const Params& P; int l; bool dry;
    __device__ __forceinline__ void operator()(Acc& acc, const Unit& u, int wr, int wc, int fr, int fq, int ui) const {
        unsigned char* ws = opaque_ptr(P.ws);
        const float* resid = l == 0 ? P.x_p : (const float*)(ws + WS_Y0); float* outp = l == 0 ? (float*)(ws + WS_Y0) : P.out + O_YP;
        bf16* hnext = (bf16*)(ws + WS_H); const float* gnext = P.g_norm + DM; float* ssqn = (float*)(ws + WS_CTL) + CW_SSQH + MA;
        const int row0 = u.pm * BM + wr * 64 + fr, col0 = u.pn * BM + wc * 32 + 8 * fq;
        f32x4 gn[2][2];
#pragma unroll
        for (int bj = 0; bj < 2; ++bj) { gn[bj][0] = *(const GAS f32x4*)(gnext + col0 + bj * 128); gn[bj][1] = *(const GAS f32x4*)(gnext + col0 + bj * 128 + 4); }
#pragma unroll
        for (int ai = 0; ai < 2; ++ai) {
            f32x4 rv[4][2][2];
#pragma unroll
            for (int m = 0; m < 4; ++m) { const size_t off = (size_t)(row0 + ai * 128 + m * 16) * DM + col0;
#pragma unroll
                for (int bj = 0; bj < 2; ++bj) { rv[m][bj][0] = __builtin_nontemporal_load((const GAS f32x4*)(resid + off + bj * 128)); rv[m][bj][1] = __builtin_nontemporal_load((const GAS f32x4*)(resid + off + bj * 128 + 4)); } }
#pragma unroll
            for (int m = 0; m < 4; ++m) { const size_t off = (size_t)(row0 + ai * 128 + m * 16) * DM + col0; float s = 0.f;
#pragma unroll
                for (int bj = 0; bj < 2; ++bj) {
                    const f32x4 y0 = rv[m][bj][0] + acc[ai][bj][m][0], y1 = rv[m][bj][1] + acc[ai][bj][m][1];
                    if (l == 1) { __builtin_nontemporal_store(y0, (GAS f32x4*)(outp + off + bj * 128)); __builtin_nontemporal_store(y1, (GAS f32x4*)(outp + off + bj * 128 + 4)); }
                    else { *(GAS f32x4*)(outp + off + bj * 128) = y0; *(GAS f32x4*)(outp + off + bj * 128 + 4) = y1; }
                    if (l == 0) { s += (y0[0] * y0[0] + y0[1] * y0[1]) + (y0[2] * y0[2] + y0[3] * y0[3]) + (y1[0] * y1[0] + y1[1] * y1[1]) + (y1[2] * y1[2] + y1[3] * y1[3]);
                        *(GAS u32x4*)(hnext + (size_t)(row0 + ai * 128 + m * 16) * HP + col0 + bj * 128) = pk8(y0 * gn[bj][0], y1 * gn[bj][1]); } }
                if (l == 0) { s += xor16(s); s = sum32(s); if (fq == 0 && !dry) atomic_addf(ssqn + row0 + ai * 128 + m * 16, s); } }
            asm volatile("" ::: "memory"); }
    }
};
struct Epi3s {
    static constexpr bool SYNC = false;
    const Params& P; int l;
    __device__ __forceinline__ void operator()(Acc& acc, const Unit& u, int wr, int wc, int fr, int fq, int ui) const {
        float* slab = (float*)(opaque_ptr(P.ws) + WS_SLAB) + (size_t)(u.ko >> 8) * MS * DM;
        store_f32(acc, slab, DM, wr * 64 + fr, u.pn * BM + wc * 32 + 8 * fq);
    }
};
}
using pg8::Acc;

namespace att {
constexpr int K_OFF = 0;
constexpr int V_OFF = 73728;
constexpr int CB_OFF = 122880;
constexpr int SCR_OFF = CB_OFF + 10240;
constexpr int RED_OFF = SCR_OFF + 2048;
static_assert(RED_OFF + 64 <= MISC_OFF, "attention LDS");
__device__ __forceinline__ int crow(int r, int hi) { return (r & 3) + 8 * (r >> 2) + 4 * hi; }
__device__ __forceinline__ int offb(int row, int ch) { return 256 * row + 16 * (ch ^ (((row & 3) << 2) | ((row >> 2) & 3))); }
#define TRRD(dst, addr, off) asm volatile("ds_read_b64_tr_b16 %0, %1 offset:%2" : "=&v"(dst) : "v"(addr), "i"(off) : "memory")

template <int NPT>
__device__ __forceinline__ void block_scan_store(float (&v)[NPT], LAS float* cb, LAS float* red, int tid) {
    const int lane = tid & 63, wid = tid >> 6;
#pragma unroll
    for (int e = 1; e < NPT; ++e) v[e] += v[e - 1];
    float tot = v[NPT - 1], inc = tot;
#pragma unroll
    for (int d = 1; d < 64; d <<= 1) { const float t = __int_as_float(__builtin_amdgcn_ds_bpermute((lane - d) << 2, __float_as_int(inc))); if (lane >= d) inc += t; }
    if (lane == 63) red[wid] = inc;
    __syncthreads();
    float off = inc - tot;
#pragma unroll
    for (int w = 0; w < 8; ++w) if (w < wid) off += red[w];
#pragma unroll
    for (int e = 0; e < NPT; ++e) cb[NPT * tid + e] = (off + v[e]) * LOG2E;
    __syncthreads();
}

template <int DQK, bool FOX>
__device__ __forceinline__ void attn_big_unit(LAS char* lds, const bf16* Q, int qp, const bf16* K0, int k0p, const bf16* K1, int k1p, const bf16* V, int vp, const bf16* G, bf16* O, int qb) {
    constexpr int RB = DQK * 2, KBUF = 64 * RB, ND = DQK / 16, NIK = KBUF / 8192;
    constexpr float C2 = FOX ? FOX_C2 : MLA_C2;
    const int tid = opaque_tid(), wid = __builtin_amdgcn_readfirstlane(tid >> 6), lane = tid & 63, r32 = lane & 31, hi = lane >> 5;
    LAS char* Kl = lds + K_OFF; LAS char* Vl = lds + V_OFF; const LAS float* cb = (const LAS float*)(lds + CB_OFF); LAS float* scr = (LAS float*)(lds + SCR_OFF) + wid * 64;
    const int NT = 4 * (qb + 1), qlo = 256 * qb + 32 * wid;
    bf16x8 qr[ND];
#pragma unroll
    for (int d0 = 0; d0 < ND; ++d0) qr[d0] = *(const GAS bf16x8*)(Q + (size_t)(qlo + r32) * qp + d0 * 16 + hi * 8);
    const GAS char* kp[NIK]; unsigned kstep[NIK]; const GAS char* vpp[2];
#pragma unroll
    for (int j = 0; j < NIK; ++j) { const int o = (wid * NIK + j) * 1024 + lane * 16, row = o / RB, cpos = (o % RB) / 16, c = DQK == 128 ? (cpos ^ (row & 15)) : ((cpos & ~7) | ((cpos ^ (row >> 1)) & 7));
        if (DQK == 192 && c >= 16) { kp[j] = (const GAS char*)(K1 + (size_t)row * k1p + (c - 16) * 8); kstep[j] = 64u * (unsigned)k1p * 2u; }
        else { kp[j] = (const GAS char*)(K0 + (size_t)row * k0p + c * 8); kstep[j] = 64u * (unsigned)k0p * 2u; } }
#pragma unroll
    for (int j = 0; j < 2; ++j) { const int o = (wid * 2 + j) * 1024 + lane * 16, row = o >> 8, cpos = (o & 255) >> 4, ch = cpos ^ (((row & 3) << 2) | ((row >> 2) & 3));
        vpp[j] = (const GAS char*)(V + (size_t)row * vp + ch * 8); }
    const unsigned vstep = 64u * (unsigned)vp * 2u;
#define DMA_TILE(kb_, vb_) do { \
        _Pragma("unroll") for (int j = 0; j < NIK; ++j) { __builtin_amdgcn_global_load_lds((const GAS unsigned*)kp[j], (LAS unsigned*)(Kl + (kb_) + (wid * NIK + j) * 1024), 16, 0, 0); kp[j] += kstep[j]; } \
        _Pragma("unroll") for (int j = 0; j < 2; ++j) { __builtin_amdgcn_global_load_lds((const GAS unsigned*)vpp[j], (LAS unsigned*)(Vl + (vb_) + (wid * 2 + j) * 1024), 16, 0, 0); vpp[j] += vstep; } } while (0)
#define WAIT_ONE_AHEAD() do { if (NIK == 3) asm volatile("s_waitcnt vmcnt(5)" ::: "memory"); else asm volatile("s_waitcnt vmcnt(4)" ::: "memory"); } while (0)
#define BARRIER() do { asm volatile("s_waitcnt lgkmcnt(0)" ::: "memory"); __builtin_amdgcn_s_barrier(); asm volatile("" ::: "memory"); } while (0)
    float m_reg = -1e30f, l_reg = 0.f; f32x16 o[4];
#pragma unroll
    for (int c = 0; c < 4; ++c) o[c] = f32x16{};
    const int hq = (lane & 15) >> 2, hp = lane & 3, hblk = (lane >> 4) & 1;
    const unsigned va0 = (unsigned)(size_t)Vl + 256 * (8 * hi + hq) + 64 * hq + 16 * ((2 * hblk + (hp >> 1)) ^ (2 * hi)) + 8 * (hp & 1);
    const int kq = r32 * RB, kswz = DQK == 128 ? ((r32 & 15) << 4) : (((r32 >> 1) & 7) << 4);
    bf16x8 pa[4];
#define PVH(vt, c0) do { s16x4 l0, l1, l2, l3, h0, h1, h2, h3, m0, m1, m2, m3, n0, n1, n2, n3; \
        const unsigned aL = (vt) ^ (unsigned)((c0) << 6), aH = (vt) ^ (unsigned)(((c0) << 6) | (1 << 4) | (1 << 10)), bL = (vt) ^ (unsigned)(((c0) + 1) << 6), bH = (vt) ^ (unsigned)((((c0) + 1) << 6) | (1 << 4) | (1 << 10)); \
        TRRD(l0, aL, 0); TRRD(h0, aH, 0); TRRD(l1, aL, 4096); TRRD(h1, aH, 4096); TRRD(l2, aL, 8192); TRRD(h2, aH, 8192); TRRD(l3, aL, 12288); TRRD(h3, aH, 12288); \
        TRRD(m0, bL, 0); TRRD(n0, bH, 0); TRRD(m1, bL, 4096); TRRD(n1, bH, 4096); TRRD(m2, bL, 8192); TRRD(n2, bH, 8192); TRRD(m3, bL, 12288); TRRD(n3, bH, 12288); \
        asm volatile("s_waitcnt lgkmcnt(0)" ::: "memory"); SBAR(); \
        o[c0] = __builtin_amdgcn_mfma_f32_32x32x16_bf16((bf16x8){l0[0], l0[1], l0[2], l0[3], h0[0], h0[1], h0[2], h0[3]}, pa[0], o[c0], 0, 0, 0); \
        o[c0 + 1] = __builtin_amdgcn_mfma_f32_32x32x16_bf16((bf16x8){m0[0], m0[1], m0[2], m0[3], n0[0], n0[1], n0[2], n0[3]}, pa[0], o[c0 + 1], 0, 0, 0); \
        o[c0] = __builtin_amdgcn_mfma_f32_32x32x16_bf16((bf16x8){l1[0], l1[1], l1[2], l1[3], h1[0], h1[1], h1[2], h1[3]}, pa[1], o[c0], 0, 0, 0); \
        o[c0 + 1] = __builtin_amdgcn_mfma_f32_32x32x16_bf16((bf16x8){m1[0], m1[1], m1[2], m1[3], n1[0], n1[1], n1[2], n1[3]}, pa[1], o[c0 + 1], 0, 0, 0); \
        o[c0] = __builtin_amdgcn_mfma_f32_32x32x16_bf16((bf16x8){l2[0], l2[1], l2[2], l2[3], h2[0], h2[1], h2[2], h2[3]}, pa[2], o[c0], 0, 0, 0); \
        o[c0 + 1] = __builtin_amdgcn_mfma_f32_32x32x16_bf16((bf16x8){m2[0], m2[1], m2[2], m2[3], n2[0], n2[1], n2[2], n2[3]}, pa[2], o[c0 + 1], 0, 0, 0); \
        o[c0] = __builtin_amdgcn_mfma_f32_32x32x16_bf16((bf16x8){l3[0], l3[1], l3[2], l3[3], h3[0], h3[1], h3[2], h3[3]}, pa[3], o[c0], 0, 0, 0); \
        o[c0 + 1] = __builtin_amdgcn_mfma_f32_32x32x16_bf16((bf16x8){m3[0], m3[1], m3[2], m3[3], n3[0], n3[1], n3[2], n3[3]}, pa[3], o[c0 + 1], 0, 0, 0); } while (0)
#define PV(vb_) do { const unsigned vt_ = va0 + (unsigned)(vb_); PVH(vt_, 0); PVH(vt_, 2); } while (0)
    DMA_TILE(0, 0);
    if (NT > 1) { DMA_TILE(KBUF, 16384); WAIT_ONE_AHEAD(); } else asm volatile("s_waitcnt vmcnt(0)" ::: "memory");
    BARRIER();
    int bcur = 0, bnxt = 1, bnn = 2;
    for (int t = 0; t < NT; ++t) {
        if (t + 2 < NT) DMA_TILE(bnn * KBUF, bnn * 16384);
        const bool act = FOX ? (64 * t <= qlo + 31) : (t <= 4 * qb + (wid >> 1));
        if (act) {
            f32x16 p0 = f32x16{}, p1 = f32x16{};
            const LAS char* kb = Kl + bcur * KBUF + kq;
            constexpr int GS = DQK == 128 ? 4 : 3, NG = ND / GS;
            bf16x8 ka[2][GS], kc[2][GS];
#define KRD(gi, sl) do { _Pragma("unroll") for (int j = 0; j < GS; ++j) { const int cB = (((gi) * GS + j) * 32 + hi * 16) ^ kswz; ka[sl][j] = *(const LAS bf16x8*)(kb + cB); kc[sl][j] = *(const LAS bf16x8*)(kb + 32 * RB + cB); } } while (0)
#define KMM(gi, sl) do { _Pragma("unroll") for (int j = 0; j < GS; ++j) { p0 = __builtin_amdgcn_mfma_f32_32x32x16_bf16(ka[sl][j], qr[(gi) * GS + j], p0, 0, 0, 0); p1 = __builtin_amdgcn_mfma_f32_32x32x16_bf16(kc[sl][j], qr[(gi) * GS + j], p1, 0, 0, 0); } } while (0)
            KRD(0, 0); SBAR(); KRD(1, 1); SBAR(); KMM(0, 0); SBAR();
            if (NG == 4) { KRD(2, 0); SBAR(); KMM(1, 1); SBAR(); KRD(3, 1); SBAR(); KMM(2, 0); SBAR(); KMM(3, 1); SBAR(); }
            else { KMM(1, 1); SBAR(); }
#undef KRD
#undef KMM
            if (FOX) {
#pragma unroll
                for (int g = 0; g < 4; ++g) { const f32x4 b0 = *(const LAS f32x4*)(cb + 64 * t + 8 * g + 4 * hi), b1 = *(const LAS f32x4*)(cb + 64 * t + 32 + 8 * g + 4 * hi);
#pragma unroll
                    for (int e = 0; e < 4; ++e) { p0[4 * g + e] = fmaf(p0[4 * g + e], C2, -b0[e]); p1[4 * g + e] = fmaf(p1[4 * g + e], C2, -b1[e]); } }
                if (64 * t + 63 > qlo) { asm volatile("" ::: "memory");
                    const int dq = qlo + r32 - 64 * t - 4 * hi; const float NEG = -__builtin_inff();
#pragma unroll
                    for (int r = 0; r < 16; ++r) { const int c = (r & 3) + 8 * (r >> 2); if (c > dq) p0[r] = NEG; if (c + 32 > dq) p1[r] = NEG; } }
            } else {
#pragma unroll
                for (int r = 0; r < 16; ++r) { p0[r] *= C2; p1[r] *= C2; }
            }
            float pmax = p0[0];
#pragma unroll
            for (int r = 1; r < 16; ++r) pmax = fmaxf(pmax, p0[r]);
#pragma unroll
            for (int r = 0; r < 16; ++r) pmax = fmaxf(pmax, p1[r]);
            pmax = max32(pmax);
            float mn, alpha;
            if (__all(pmax - m_reg <= 8.0f)) { mn = m_reg; alpha = 1.f; }
            else { mn = fmaxf(m_reg, pmax); alpha = __builtin_amdgcn_exp2f(m_reg - mn); m_reg = mn; }
            float ps = 0.f;
#pragma unroll
            for (int r = 0; r < 16; ++r) { p0[r] = __builtin_amdgcn_exp2f(p0[r] - mn); p1[r] = __builtin_amdgcn_exp2f(p1[r] - mn); ps += p0[r] + p1[r]; }
            ps = sum32(ps);
            l_reg = l_reg * alpha + ps;
            if (__any(alpha < 1.f)) {
#pragma unroll
                for (int c = 0; c < 4; ++c) o[c] *= alpha; }
#define PK4(P, B_, OUT) do { unsigned a0_ = cvtpk(P[B_ + 0], P[B_ + 1]), a1_ = cvtpk(P[B_ + 2], P[B_ + 3]), b0_ = cvtpk(P[B_ + 4], P[B_ + 5]), b1_ = cvtpk(P[B_ + 6], P[B_ + 7]); \
        auto r0_ = __builtin_amdgcn_permlane32_swap(a0_, b0_, false, false); auto r1_ = __builtin_amdgcn_permlane32_swap(a1_, b1_, false, false); \
        u32x4 w_ = {r0_[0], r1_[0], r0_[1], r1_[1]}; OUT = __builtin_bit_cast(bf16x8, w_); } while (0)
            PK4(p0, 0, pa[0]); PK4(p0, 8, pa[1]); PK4(p1, 0, pa[2]); PK4(p1, 8, pa[3]);
#undef PK4
            PV(bcur * 16384);
        }
        if (t + 2 < NT) WAIT_ONE_AHEAD(); else asm volatile("s_waitcnt vmcnt(0)" ::: "memory");
        BARRIER();
        { const int tmp_ = bcur; bcur = bnxt; bnxt = bnn; bnn = tmp_; }
    }
#undef PV
#undef PVH
#undef DMA_TILE
#undef WAIT_ONE_AHEAD
#undef BARRIER
    { const float rl = __builtin_amdgcn_rcpf(l_reg); const size_t ro = (size_t)(qlo + r32) * DM + 4 * hi, oo = (size_t)(qlo + r32) * OP + 8 * hi;
      u32x2 gt[4][4];
#pragma unroll
      for (int c = 0; c < 4; ++c)
#pragma unroll
          for (int g = 0; g < 4; ++g) gt[c][g] = *(const GAS u32x2*)(G + ro + 32 * c + 8 * g);
#pragma unroll
      for (int c = 0; c < 4; ++c)
#pragma unroll
          for (int gp = 0; gp < 2; ++gp) { unsigned w[2][2];
#pragma unroll
              for (int k = 0; k < 2; ++k) { const int g = 2 * gp + k; const u32x2 gg = gt[c][g];
                  const float g0 = __uint_as_float(gg[0] << 16), g1 = __uint_as_float(gg[0] & 0xffff0000u), g2 = __uint_as_float(gg[1] << 16), g3 = __uint_as_float(gg[1] & 0xffff0000u);
                  w[k][0] = cvtpk(o[c][4 * g + 0] * rl * g0, o[c][4 * g + 1] * rl * g1); w[k][1] = cvtpk(o[c][4 * g + 2] * rl * g2, o[c][4 * g + 3] * rl * g3); }
              auto r0 = __builtin_amdgcn_permlane32_swap(w[0][0], w[1][0], false, false); auto r1 = __builtin_amdgcn_permlane32_swap(w[0][1], w[1][1], false, false);
              u32x4 st = {r0[0], r1[0], r0[1], r1[1]};
              *(GAS u32x4*)(O + oo + 32 * c + 16 * gp) = st; } }
    asm volatile("s_waitcnt vmcnt(0) lgkmcnt(0)" ::: "memory");
    __builtin_amdgcn_s_barrier();
}

template <int DQK, bool FOX>
__device__ __forceinline__ void attn_small_unit(LAS char* lds, const bf16* Q, int qp, const float* cK, const float* cV, const bf16* nK, const bf16* nV,
                                                const bf16* K0, const bf16* K1, const bf16* V, const bf16* G, bf16* O, const float* gkn = nullptr) {
    constexpr int RB = DQK * 2, NS = DQK / 32;
    constexpr float C2 = FOX ? FOX_C2 : MLA_C2;
    const int tid = opaque_tid(), wid = __builtin_amdgcn_readfirstlane(tid >> 6), lane = tid & 63, fr = lane & 15, fq = lane >> 4;
    LAS char* Kl = lds + K_OFF; LAS char* Vl = lds + V_OFF; const LAS float* cb = (const LAS float*)(lds + CB_OFF);
    bf16x8 qf[NS];
#pragma unroll
    for (int s = 0; s < NS; ++s) qf[s] = *(const GAS bf16x8*)(Q + (size_t)fr * qp + 32 * s + 8 * fq);
    const int srow = tid >> 2, sq = tid & 3;
    const int kswr = (srow & 7) << 4;
    float m_reg = -1e30f, l_reg = 0.f; f32x4 o[8];
#pragma unroll
    for (int c = 0; c < 8; ++c) o[c] = (f32x4){0.f, 0.f, 0.f, 0.f};
    const int krow = 16 * wid + fr, kswz = (krow & 7) << 4;
    const int hq = (lane & 15) >> 2, hp = lane & 3, vrow = 16 * wid + 4 * fq + hq;
    const unsigned va0 = (unsigned)(size_t)Vl + 256 * vrow + 16 * ((hp >> 1) ^ (4 * hq + fq)) + 8 * (hp & 1);
    auto process = [&](int t) {
        f32x4 s = {0.f, 0.f, 0.f, 0.f};
        const LAS char* kb = Kl + krow * RB;
#pragma unroll
        for (int st = 0; st < NS; ++st) { const bf16x8 kf = *(const LAS bf16x8*)(kb + ((64 * st + 16 * fq) ^ kswz)); s = __builtin_amdgcn_mfma_f32_16x16x32_bf16(kf, qf[st], s, 0, 0, 0); }
        const int key0 = 128 * t + 16 * wid + 4 * fq;
        if (FOX) { const f32x4 bb = *(const LAS f32x4*)(cb + key0);
#pragma unroll
            for (int e = 0; e < 4; ++e) s[e] = fmaf(s[e], C2, -bb[e]); }
        else { s *= C2; }
        const float NEG = -__builtin_inff();
#pragma unroll
        for (int e = 0; e < 4; ++e) { const int key = key0 + e; if (key >= SKV || (FOX && key > PAST + fr)) s[e] = NEG; }
        float pmax = fmaxf(fmaxf(s[0], s[1]), fmaxf(s[2], s[3]));
        pmax = fmaxf(pmax, xor16(pmax)); pmax = max32(pmax);
        const float mn = fmaxf(m_reg, pmax), alpha = __builtin_amdgcn_exp2f(m_reg - mn); m_reg = mn;
        float p[4], ps = 0.f;
#pragma unroll
        for (int e = 0; e < 4; ++e) { p[e] = __builtin_amdgcn_exp2f(s[e] - mn); ps += p[e]; }
        ps += xor16(ps); ps = sum32(ps);
        l_reg = l_reg * alpha + ps;
        u32x4 pw = {cvtpk(p[0], p[1]), cvtpk(p[2], p[3]), 0u, 0u}; const bf16x8 pf = __builtin_bit_cast(bf16x8, pw);
        s16x4 v0, v1, v2, v3, v4, v5, v6, v7;
        TRRD(v0, va0, 0); TRRD(v1, va0 ^ 32u, 0); TRRD(v2, va0 ^ 64u, 0); TRRD(v3, va0 ^ 96u, 0); TRRD(v4, va0 ^ 128u, 0); TRRD(v5, va0 ^ 160u, 0); TRRD(v6, va0 ^ 192u, 0); TRRD(v7, va0 ^ 224u, 0);
        asm volatile("s_waitcnt lgkmcnt(0)" ::: "memory"); SBAR();
#define PVS(c, vv) o[c] = __builtin_amdgcn_mfma_f32_16x16x32_bf16((bf16x8){vv[0], vv[1], vv[2], vv[3], 0, 0, 0, 0}, pf, o[c] * alpha, 0, 0, 0)
        PVS(0, v0); PVS(1, v1); PVS(2, v2); PVS(3, v3); PVS(4, v4); PVS(5, v5); PVS(6, v6); PVS(7, v7);
#undef PVS
    };
    if constexpr (FOX) {
        f32x4 fk[8], fv[8];
        const int pc = tid & 31, rb = tid >> 5;
        const float* kp = cK + (size_t)rb * 2048 + pc * 4; const float* vp_ = cV + (size_t)rb * 2048 + pc * 4;
        const int kwf = rb * RB + (((pc >> 1) * 16) ^ ((rb & 7) << 4)) + (pc & 1) * 8, vwf = offb(rb, pc >> 1) + (pc & 1) * 8;
#define LOADF(t) do { _Pragma("unroll") for (int i = 0; i < 8; ++i) { fk[i] = __builtin_nontemporal_load((const GAS f32x4*)(kp + ((size_t)(t) * 128 + 16 * i) * 2048)); fv[i] = __builtin_nontemporal_load((const GAS f32x4*)(vp_ + ((size_t)(t) * 128 + 16 * i) * 2048)); } } while (0)
#define WRITEF() do { _Pragma("unroll") for (int i = 0; i < 8; ++i) { u32x2 kw_ = {cvtpk(fk[i][0], fk[i][1]), cvtpk(fk[i][2], fk[i][3])}, vw_ = {cvtpk(fv[i][0], fv[i][1]), cvtpk(fv[i][2], fv[i][3])}; \
            *(LAS u32x2*)(Kl + kwf + 16 * i * RB) = kw_; *(LAS u32x2*)(Vl + vwf + 16 * i * 256) = vw_; } } while (0)
        LOADF(0);
        for (int t = 0; t < 16; ++t) {
            WRITEF();
            __syncthreads();
            if (t + 1 < 16) LOADF(t + 1);
            process(t);
            __syncthreads();
        }
#undef LOADF
#undef WRITEF
#pragma unroll
        for (int i = 0; i < 4; ++i) { bf16x8 a = {}, b = {};
            if (srow < 16) { a = *(const GAS bf16x8*)(nK + (size_t)srow * FW + sq * 32 + 8 * i); b = *(const GAS bf16x8*)(nV + (size_t)srow * FW + sq * 32 + 8 * i); }
            *(LAS bf16x8*)(Kl + srow * RB + (((sq * 4 + i) * 16) ^ kswr)) = a; *(LAS bf16x8*)(Vl + offb(srow, sq * 4 + i)) = b; }
        __syncthreads();
        process(16);
        __syncthreads();
    } else {
        bf16x8 bk[4], bk1[2], bv[4];
        const int c16 = tid & 15, rb16 = tid >> 4, c8 = tid & 7, rb8 = tid >> 3;
        const int kwb = rb16 * RB + ((c16 * 16) ^ ((rb16 & 7) << 4)), vwb = offb(rb16, c16), k1wb = rb8 * RB + 256 + ((c8 * 16) ^ ((rb8 & 7) << 4));
#define LOADB(t) do { \
            _Pragma("unroll") for (int i = 0; i < 4; ++i) { int rowc_ = 128 * (t) + rb16 + 32 * i; rowc_ = rowc_ < SKV ? rowc_ : SKV - 1; \
                bk[i] = __builtin_nontemporal_load((const GAS bf16x8*)(K0 + (size_t)rowc_ * 4096 + c16 * 8)); bv[i] = __builtin_nontemporal_load((const GAS bf16x8*)(V + (size_t)rowc_ * 4096 + c16 * 8)); } \
            _Pragma("unroll") for (int i = 0; i < 2; ++i) { int rowc_ = 128 * (t) + rb8 + 64 * i; rowc_ = rowc_ < SKV ? rowc_ : SKV - 1; bk1[i] = *(const GAS bf16x8*)(K1 + (size_t)rowc_ * 64 + c8 * 8); } } while (0)
        const f32x4 gk0 = *(const GAS f32x4*)(gkn + c16 * 8), gk1 = *(const GAS f32x4*)(gkn + c16 * 8 + 4);
        LOADB(0);
        for (int t = 0; t < 17; ++t) {
            if (t < 16) {
#pragma unroll
                for (int i = 0; i < 4; ++i) { const u32x4 w = __builtin_bit_cast(u32x4, bk[i]); float f[8];
#pragma unroll
                    for (int e = 0; e < 4; ++e) { f[2 * e] = __uint_as_float(w[e] << 16); f[2 * e + 1] = __uint_as_float(w[e] & 0xffff0000u); }
                    float ss = (f[0] * f[0] + f[1] * f[1]) + (f[2] * f[2] + f[3] * f[3]) + (f[4] * f[4] + f[5] * f[5]) + (f[6] * f[6] + f[7] * f[7]);
                    ss += swz_xor(ss, SWZ_X1); ss += swz_xor(ss, SWZ_X2); ss += swz_xor(ss, SWZ_X4); ss += swz_xor(ss, SWZ_X8);
                    const float rn = rsqrtf(ss * (1.0f / 128) + EPS);
                    u32x4 o_ = {cvtpk(f[0] * rn * gk0[0], f[1] * rn * gk0[1]), cvtpk(f[2] * rn * gk0[2], f[3] * rn * gk0[3]), cvtpk(f[4] * rn * gk1[0], f[5] * rn * gk1[1]), cvtpk(f[6] * rn * gk1[2], f[7] * rn * gk1[3])};
                    bk[i] = __builtin_bit_cast(bf16x8, o_); } }
#pragma unroll
            for (int i = 0; i < 4; ++i) { *(LAS bf16x8*)(Kl + kwb + 32 * i * RB) = bk[i]; *(LAS bf16x8*)(Vl + vwb + 32 * i * 256) = bv[i]; }
#pragma unroll
            for (int i = 0; i < 2; ++i) *(LAS bf16x8*)(Kl + k1wb + 64 * i * RB) = bk1[i];
            __syncthreads();
            if (t + 1 < 17) LOADB(t + 1);
            process(t);
            __syncthreads();
        }
#undef LOADB
    }
    LAS float* Ow = (LAS float*)(lds + K_OFF); LAS float* ml = (LAS float*)(lds + K_OFF + 65536);
#pragma unroll
    for (int c = 0; c < 8; ++c) *(LAS f32x4*)(Ow + (wid * 16 + fr) * 128 + 16 * c + 4 * fq) = o[c];
    if (fq == 0) { ml[wid * 32 + fr] = m_reg; ml[wid * 32 + 16 + fr] = l_reg; }
    __syncthreads();
    { const int q = tid >> 5, dg = tid & 31; float M = -1e30f;
#pragma unroll
      for (int w = 0; w < 8; ++w) M = fmaxf(M, ml[w * 32 + q]);
      float L = 0.f; f32x4 a = {0.f, 0.f, 0.f, 0.f};
#pragma unroll
      for (int w = 0; w < 8; ++w) { const float wt = __builtin_amdgcn_exp2f(ml[w * 32 + q] - M); L += wt * ml[w * 32 + 16 + q]; a += wt * *(const LAS f32x4*)(Ow + (w * 16 + q) * 128 + 4 * dg); }
      const float rl = 1.0f / L; const size_t ro = (size_t)q * DM + 4 * dg;
      const u32x2 gv = *(const GAS u32x2*)(G + ro);
      const float g0 = __uint_as_float(gv[0] << 16), g1 = __uint_as_float(gv[0] & 0xffff0000u), g2 = __uint_as_float(gv[1] << 16), g3 = __uint_as_float(gv[1] & 0xffff0000u);
      u32x2 w = {cvtpk(a[0] * rl * g0, a[1] * rl * g1), cvtpk(a[2] * rl * g2, a[3] * rl * g3)}; *(GAS u32x2*)(O + (size_t)q * OP + 4 * dg) = w; }
    __syncthreads();
}
}

struct Frame { LAS unsigned char* lds; int tid, lane, wave, vcu, G; };

enum { WK_IN = 0, WK_80 = 1, WK_QB = 2, WK_KVB = 3, WK_OUT = 4 };
__device__ __forceinline__ int srccol(int kind, int n) {
    if (kind == WK_IN) return n < 6144 ? n : (n < 8192 ? n + 16 : (n < 10240 ? n + 1616 : n - 2032));
    if (kind == WK_80) return n < 16 ? 6144 + n : (n < 80 ? 9728 + n : -1);
    if (kind == WK_QB) { if (n < 2048) return (n >> 7) * 192 + (n & 127); const int m = n - 2048; return (m >> 6) * 192 + 128 + ((m & 63) >> 1) + 32 * (m & 1); }
    return n;
}
__device__ __forceinline__ void transpose_item(const float* W, int Nsrc, int kind, bf16* WT, int wtp, int nblk, int ncol0, LAS float* scr, int item, int lane) {
    const int kb = item / nblk, nb = item % nblk, k0 = 64 * kb, n0 = ncol0 + 32 * nb;
    const int sc = srccol(kind, n0 + (lane & 31));
#pragma unroll 8
    for (int i = 0; i < 32; ++i) { const int kk = 2 * i + (lane >> 5); scr[kk * 33 + (lane & 31)] = sc >= 0 ? ((const GAS float*)W)[(size_t)(k0 + kk) * Nsrc + sc] : 0.f; }
    LDS_WAIT(); asm volatile("" ::: "memory");
    const int c = lane & 7;
#pragma unroll
    for (int j = 0; j < 4; ++j) { const int n = (lane >> 3) + 8 * j; const LAS float* s = scr + (8 * c) * 33 + n;
        u32x4 o; o.x = cvtpk(s[0 * 33], s[1 * 33]); o.y = cvtpk(s[2 * 33], s[3 * 33]); o.z = cvtpk(s[4 * 33], s[5 * 33]); o.w = cvtpk(s[6 * 33], s[7 * 33]);
        *(GAS u32x4*)(WT + (size_t)(n0 + n) * wtp + k0 + 8 * c) = o; }
    LDS_WAIT(); asm volatile("" ::: "memory");
}
__device__ __forceinline__ void transpose_item64(const float* W, int Nsrc, int kind, bf16* WT, int wtp, int nblk, LAS unsigned char* T, int item, int lane) {
    const int kb = item / nblk, nb = item % nblk, k0 = 64 * kb, n0 = 64 * nb;
    const int g = lane >> 4, c = lane & 15;
    const float* src = W + (size_t)(k0 + 16 * g) * Nsrc + srccol(kind, n0 + 4 * c);
    f32x4 v[16];
#pragma unroll
    for (int i = 0; i < 16; ++i) v[i] = __builtin_nontemporal_load((const GAS f32x4*)(src + (size_t)i * Nsrc));
#pragma unroll
    for (int j = 0; j < 4; ++j) { const int row = 4 * c + j;
        u32x4 lo = {cvtpk(v[0][j], v[1][j]), cvtpk(v[2][j], v[3][j]), cvtpk(v[4][j], v[5][j]), cvtpk(v[6][j], v[7][j])};
        u32x4 hi = {cvtpk(v[8][j], v[9][j]), cvtpk(v[10][j], v[11][j]), cvtpk(v[12][j], v[13][j]), cvtpk(v[14][j], v[15][j])};
        *(LAS u32x4*)(T + row * 128 + (((2 * g) ^ (c & 7)) * 16)) = lo; *(LAS u32x4*)(T + row * 128 + (((2 * g + 1) ^ (c & 7)) * 16)) = hi; }
    LDS_WAIT(); asm volatile("" ::: "memory");
#pragma unroll
    for (int i = 0; i < 8; ++i) { const int row = 8 * i + (lane >> 3), ch = lane & 7;
        const u32x4 o = *(const LAS u32x4*)(T + row * 128 + ((ch ^ ((row >> 2) & 7)) * 16));
        *(GAS u32x4*)(WT + (size_t)(n0 + row) * wtp + k0 + 8 * ch) = o; }
    LDS_WAIT(); asm volatile("" ::: "memory");
}
__device__ __forceinline__ float row_to_h(const float* xrow, const float* g, bf16* hrow, int lane) {
    float ss = 0.f; f32x4 v[16], gg[16];
#pragma unroll
    for (int j = 0; j < 16; ++j) v[j] = __builtin_nontemporal_load((const GAS f32x4*)(xrow + 4 * lane + 256 * j));
#pragma unroll
    for (int j = 0; j < 16; ++j) gg[j] = *(const GAS f32x4*)(g + 4 * lane + 256 * j);
#pragma unroll
    for (int j = 0; j < 16; ++j) {
        ss += (v[j][0] * v[j][0] + v[j][1] * v[j][1]) + (v[j][2] * v[j][2] + v[j][3] * v[j][3]); const f32x4 h = v[j] * gg[j];
        u32x2 w = {cvtpk(h[0], h[1]), cvtpk(h[2], h[3])}; *(GAS u32x2*)(hrow + 4 * lane + 256 * j) = w; }
    return wave_sum(ss);
}
#ifndef PH_ATTR
#define PH_ATTR __forceinline__
#endif
#define PHASE_FRAME(F0) Frame F = F0; F.tid = opaque_tid(); F.lane = F.tid & 63; asm volatile("" : "+s"(F.vcu), "+s"(F.G), "+s"(F.wave))
template <int PART>
__device__ __forceinline__ void convert_work(const Frame& F0, const Params& P) {
    PHASE_FRAME(F0);
    unsigned char* ws = opaque_ptr(P.ws);
    LAS unsigned char* T = F.lds + F.wave * 16384; LAS float* scr = (LAS float*)T;
    const int gw = F.vcu * 8 + F.wave, NGW = F.G * 8;
    constexpr int I_IN = 64 * (N1 / 64), I_OUT = 64 * 64, I_KVB = 8 * 64, I_QBN = 16 * 32, I_QBR = 16 * 32, I_80 = 64 * 3;
    if constexpr (PART == 0) {
        for (int it = gw; it < I_IN + I_80; it += NGW) {
            if (it < I_IN) transpose_item64(P.w_in, NIN, WK_IN, (bf16*)(ws + WS_WIN), WP, N1 / 64, T, it, F.lane);
            else transpose_item(P.w_in, NIN, WK_80, (bf16*)(ws + WS_W80), DM, 3, 0, scr, it - I_IN, F.lane);
        }
        { bf16* H = (bf16*)(ws + WS_H); float* ssq = (float*)(ws + WS_CTL) + CW_SSQH;
          for (int m = gw; m < MA; m += NGW) { const float* xr = m < MP ? P.x_p + (size_t)m * DM : P.x_s + (size_t)(m - MP) * DM;
              const float s = row_to_h(xr, P.g_norm, H + (size_t)m * HP, F.lane); if (F.lane == 0) ((GAS float*)ssq)[m] = s; } }
        const size_t gt = (size_t)F.vcu * 512 + F.tid, NGT = (size_t)F.G * 512;
        for (size_t i = gt; i < (size_t)SKV * 32; i += NGT) { const int pos = (int)(i >> 5), k = (int)(i & 31); const float inv = 1.0f / powf(10000.0f, (float)k / 32.0f); const float ang = (float)pos * inv;
            float sn, cs; sincosf(ang, &sn, &cs); GAS float* t = (GAS float*)(ws + WS_ROPE) + i * 2; t[0] = cs; t[1] = sn; }
    } else {
        constexpr int N1_ = I_IN, N2_ = N1_ + 2 * I_OUT, N3_ = N2_ + 2 * I_KVB, N4_ = N3_ + 2 * I_QBN, N5_ = N4_ + 2 * I_QBR, N6_ = N5_ + I_80;
        for (int it = gw; it < N6_; it += NGW) {
            if (it < N1_) { transpose_item64(P.w_in + (size_t)DM * NIN, NIN, WK_IN, (bf16*)(ws + WS_WIN + AL(SZ_WIN)), WP, N1 / 64, T, it, F.lane); continue; }
            if (it < N2_) { const int r = it - N1_, l = r / I_OUT; transpose_item64(P.w_out + (size_t)l * DM * DM, DM, WK_OUT, (bf16*)(ws + WS_WOUT + l * AL(SZ_WOUT)), WP, 64, T, r % I_OUT, F.lane); continue; }
            if (it < N3_) { const int r = it - N2_, l = r / I_KVB; transpose_item64(P.w_kvb + (size_t)l * KVL * 4096, 4096, WK_KVB, (bf16*)(ws + WS_WKVB + l * AL(SZ_WKVB)), KVL, 64, T, r % I_KVB, F.lane); continue; }
            if (it < N4_) { const int r = it - N3_, l = r / I_QBN; transpose_item64(P.w_qb + (size_t)l * QL * 3072, 3072, WK_QB, (bf16*)(ws + WS_WQB + l * AL(SZ_WQB)), QL, 32, T, r % I_QBN, F.lane); continue; }
            if (it < N5_) { const int r = it - N4_, l = r / I_QBR; transpose_item(P.w_qb + (size_t)l * QL * 3072, 3072, WK_QB, (bf16*)(ws + WS_WQB + l * AL(SZ_WQB)), QL, 32, 2048, scr, r % I_QBR, F.lane); continue; }
            transpose_item(P.w_in + (size_t)DM * NIN, NIN, WK_80, (bf16*)(ws + WS_W80 + AL(SZ_W80)), DM, 3, 0, scr, it - N5_, F.lane);
        }
        const size_t gt = (size_t)F.vcu * 512 + F.tid, NGT = (size_t)F.G * 512;
        { constexpr size_t per = (size_t)DBATCH * PAST * KVL / 8;
          for (size_t i0 = gt; i0 < 2 * per; i0 += 4 * NGT) { f32x4 a[4], b[4];
#pragma unroll
              for (int u = 0; u < 4; ++u) { const size_t i = i0 + u * NGT; if (i < 2 * per) { a[u] = __builtin_nontemporal_load((const GAS f32x4*)(P.c_ckv + i * 8)); b[u] = __builtin_nontemporal_load((const GAS f32x4*)(P.c_ckv + i * 8 + 4)); } }
#pragma unroll
              for (int u = 0; u < 4; ++u) { const size_t i = i0 + u * NGT; if (i < 2 * per) { const int l = (int)(i / per); const size_t j = i % per;
                  *(GAS bf16x8*)((bf16*)(ws + WS_CKVA + l * AL(SZ_CKVA)) + (size_t)MA * KVL + j * 8) = pack8(a[u], b[u]); } } } }
        for (size_t i = gt; i < (size_t)2 * DBATCH * PAST * 8; i += NGT) { const size_t per = (size_t)DBATCH * PAST * 8; const int l = (int)(i / per); const size_t j = i % per; const int row = (int)(j >> 3), c8 = (int)(j & 7);
            const float* s = P.c_kpe + ((size_t)l * per + j) * 8; bf16* d = (bf16*)(ws + WS_KPES + l * AL(SZ_KPES)) + (size_t)((row >> 11) * SKV + (row & (PAST - 1))) * 64 + c8 * 8;
            *(GAS bf16x8*)d = pack8(*(const GAS f32x4*)s, *(const GAS f32x4*)(s + 4)); }
    }
}

__device__ __forceinline__ void skinny_item(const Frame& F0, const Params& P, int l, int item) {
    PHASE_FRAME(F0);
    unsigned char* ws = opaque_ptr(P.ws);
    const bf16* H = (const bf16*)(ws + WS_H); const bf16* W = (const bf16*)(ws + WS_W80 + l * AL(SZ_W80));
    const int lane = F.lane, w = F.wave, r0 = 96 * item;
    const int fr = lane & 15, fq = lane >> 4;
    f32x4 acc[6][6];
#pragma unroll
    for (int tb = 0; tb < 6; ++tb)
#pragma unroll
        for (int cbk = 0; cbk < 6; ++cbk) acc[tb][cbk] = (f32x4){0.f, 0.f, 0.f, 0.f};
    const bf16* hp = H + (size_t)(r0 + fr) * HP + 512 * w + 8 * fq; const bf16* wp = W + (size_t)fr * DM + 512 * w + 8 * fq;
#pragma unroll 2
    for (int st = 0; st < 16; ++st) { bf16x8 hb[6], wa[6];
#pragma unroll
        for (int tb = 0; tb < 6; ++tb) hb[tb] = *(const GAS bf16x8*)(hp + (size_t)tb * 16 * HP + 32 * st);
#pragma unroll
        for (int cbk = 0; cbk < 6; ++cbk) wa[cbk] = *(const GAS bf16x8*)(wp + (size_t)cbk * 16 * DM + 32 * st);
#pragma unroll
        for (int tb = 0; tb < 6; ++tb)
#pragma unroll
            for (int cbk = 0; cbk < 6; ++cbk) acc[tb][cbk] = __builtin_amdgcn_mfma_f32_16x16x32_bf16(wa[cbk], hb[tb], acc[tb][cbk], 0, 0, 0); }
    LAS float* part = (LAS float*)F.lds;
#pragma unroll
    for (int p = 0; p < 3; ++p) {
#pragma unroll
        for (int tbl = 0; tbl < 2; ++tbl)
#pragma unroll
            for (int cbk = 0; cbk < 6; ++cbk)
#pragma unroll
                for (int r = 0; r < 4; ++r) part[(w * 96 + 16 * cbk + 4 * fq + r) * 33 + 16 * tbl + fr] = acc[2 * p + tbl][cbk][r];
        __syncthreads();
        { const int tok = F.tid >> 4, j = F.tid & 15, row = r0 + 32 * p + tok; float f = 0.f, x1a = 0.f, x1b = 0.f, x2a = 0.f, x2b = 0.f;
#pragma unroll
          for (int ww = 0; ww < 8; ++ww) { const LAS float* pp = part + ww * 96 * 33 + tok; f += pp[j * 33]; x1a += pp[(16 + 2 * j) * 33]; x1b += pp[(17 + 2 * j) * 33]; x2a += pp[(48 + 2 * j) * 33]; x2b += pp[(49 + 2 * j) * 33]; }
          const float* ssq = (const float*)(ws + WS_CTL) + CW_SSQH + l * MA; const float rs = rsqrtf(((const GAS float*)ssq)[row] * (1.0f / DM) + EPS);
          f *= rs; x1a *= rs; x1b *= rs; x2a *= rs; x2b *= rs;
          const float z = f + ((const GAS float*)P.b_f)[l * 16 + j]; const float lf = fminf(z, 0.f) - log1pf(__expf(-fabsf(z)));
          const bool smp = row >= MP; const int rr = smp ? row - MP : row;
          ((GAS float*)(ws + WS_LOGF))[row * 16 + j] = lf;
          ((GAS float*)(smp ? P.out + O_FLS + (size_t)l * MS * 16 : P.out + O_FLP + (size_t)l * MP * 16))[(size_t)rr * 16 + j] = lf;
          float ss = (x1a * x1a + x1b * x1b) + (x2a * x2a + x2b * x2b);
          ss += swz_xor(ss, SWZ_X1); ss += swz_xor(ss, SWZ_X2); ss += swz_xor(ss, SWZ_X4); ss += swz_xor(ss, SWZ_X8);
          const float rn = rsqrtf(ss * (1.0f / 64) + EPS); const GAS float* gk = (const GAS float*)P.g_kp + l * 64;
          x1a *= rn * gk[2 * j]; x1b *= rn * gk[2 * j + 1]; x2a *= rn * gk[32 + 2 * j]; x2b *= rn * gk[33 + 2 * j];
          const int pos = smp ? PAST + (rr & 15) : (row & (SEQ - 1));
          const f32x4 cs = *(const GAS f32x4*)((const float*)(ws + WS_ROPE) + ((size_t)pos * 32 + 2 * j) * 2);
          const float o1a = x1a * cs[0] - x2a * cs[1], o2a = x2a * cs[0] + x1a * cs[1], o1b = x1b * cs[2] - x2b * cs[3], o2b = x2b * cs[2] + x1b * cs[3];
          float* ko = (smp ? P.out + O_KPES + (size_t)l * MS * 64 : P.out + O_KPEP + (size_t)l * MP * 64) + (size_t)rr * 64;
          *(GAS f32x2*)(ko + 2 * j) = (f32x2){o1a, o1b}; *(GAS f32x2*)(ko + 32 + 2 * j) = (f32x2){o2a, o2b};
          bf16* kb = smp ? (bf16*)(ws + WS_KPES + l * AL(SZ_KPES)) + (size_t)((rr >> 4) * SKV + PAST + (rr & 15)) * 64 : (bf16*)(ws + WS_KPEP) + (size_t)row * 64;
          *(GAS unsigned*)(kb + 2 * j) = cvtpk(o1a, o1b); *(GAS unsigned*)(kb + 32 + 2 * j) = cvtpk(o2a, o2b); }
        __syncthreads();
    }
}
__device__ PH_ATTR void mid_side_jobs(const Frame& F0, const Params& P, int l) {
    PHASE_FRAME(F0);
    unsigned char* ws = opaque_ptr(P.ws);
    { const int bx = (int)blockIdx.x;
      if (F.G == 256) { if (bx >= 156 && bx < 156 + MA / 96) skinny_item(F, P, l, bx - 156); }
      else for (int it = bx; it < MA / 96; it += F.G) skinny_item(F, P, l, it); }
    const int gw = F.vcu * 8 + F.wave, NGW = F.G * 8; const float* ssq = (const float*)(ws + WS_CTL) + CW_SSQCKV + l * MA;
    for (int m = gw; m < MA; m += NGW) { const float rs = rsqrtf(((const GAS float*)ssq)[m] * (1.0f / KVL) + EPS);
        float* o = m < MP ? P.out + O_CKVP + ((size_t)l * MP + m) * KVL : P.out + O_CKVS + ((size_t)l * MS + (m - MP)) * KVL;
#pragma unroll
        for (int j = 0; j < 2; ++j) { f32x4 v = *(GAS f32x4*)(o + 4 * F.lane + 256 * j); v *= rs; *(GAS f32x4*)(o + 4 * F.lane + 256 * j) = v; } }
}
__device__ PH_ATTR void fin_phase(const Frame& F0, const Params& P, int l) {
    PHASE_FRAME(F0);
    unsigned char* ws = opaque_ptr(P.ws); const int gw = F.vcu * 8 + F.wave, NGW = F.G * 8;
    const float* slab = (const float*)(ws + WS_SLAB); float* y0s = (float*)(ws + WS_Y0) + (size_t)MP * DM; float* ssq = (float*)(ws + WS_CTL) + CW_SSQH + MA;
    for (int r = gw; r < MS; r += NGW) { float ss = 0.f;
        const float* rs = l == 0 ? P.x_s + (size_t)r * DM : y0s + (size_t)r * DM; float* dst = l == 0 ? y0s + (size_t)r * DM : P.out + O_YS + (size_t)r * DM;
        f32x4 v[16];
#pragma unroll
        for (int j = 0; j < 16; ++j) v[j] = *(const GAS f32x4*)(rs + 4 * F.lane + 256 * j);
#pragma unroll 4
        for (int k = 0; k < 16; ++k) {
#pragma unroll
            for (int j = 0; j < 16; ++j) v[j] += *(const GAS f32x4*)(slab + ((size_t)k * MS + r) * DM + 4 * F.lane + 256 * j); }
        f32x4 gg[16];
#pragma unroll
        for (int j = 0; j < 16; ++j) gg[j] = *(const GAS f32x4*)(P.g_norm + DM + 4 * F.lane + 256 * j);
#pragma unroll
        for (int j = 0; j < 16; ++j) { const int c = 4 * F.lane + 256 * j;
            *(GAS f32x4*)(dst + c) = v[j];
            if (l == 0) { ss += (v[j][0] * v[j][0] + v[j][1] * v[j][1]) + (v[j][2] * v[j][2] + v[j][3] * v[j][3]); const f32x4 h = v[j] * gg[j];
                u32x2 w = {cvtpk(h[0], h[1]), cvtpk(h[2], h[3])}; *(GAS u32x2*)((bf16*)(ws + WS_H) + (size_t)(MP + r) * HP + c) = w; } }
        if (l == 0) { ss = wave_sum(ss); if (F.lane == 0) ((GAS float*)ssq)[MP + r] = ss; } }
}

__device__ __forceinline__ void att_sample_units(const Frame& F0, const Params& P, int l) {
    PHASE_FRAME(F0);
    unsigned char* ws = opaque_ptr(P.ws); LAS char* lds = (LAS char*)F.lds;
    LAS float* cb = (LAS float*)(lds + att::CB_OFF); LAS float* red = (LAS float*)(lds + att::RED_OFF);
    const bf16* QF = (const bf16*)(ws + WS_QF); const bf16* KF = (const bf16*)(ws + WS_KF); const bf16* VF = (const bf16*)(ws + WS_VF);
    const bf16* GATE = (const bf16*)(ws + WS_GATE); bf16* OB = (bf16*)(ws + WS_O); const bf16* QN = (const bf16*)(ws + WS_QN);
    const bf16* KVP = (const bf16*)(ws + WS_KVP); const bf16* KVS = (const bf16*)(ws + WS_KVS); const bf16* KPEP = (const bf16*)(ws + WS_KPEP);
    const bf16* KPES = (const bf16*)(ws + WS_KPES + l * AL(SZ_KPES)); const float* LOGF = (const float*)(ws + WS_LOGF);
    for (int u = F.vcu; u < DBATCH * 16; u += F.G) { const int b = u >> 4, h = u & 15; const size_t qrow = (size_t)MP + b * DSEQ;
        { float v[5]; const int tid_s = opaque_tid();
#pragma unroll
          for (int e = 0; e < 5; ++e) { const int j = 5 * tid_s + e; v[e] = j < PAST ? ((const GAS float*)P.c_fl)[(((size_t)l * DBATCH + b) * PAST + j) * 16 + h] : (j < SKV ? ((const GAS float*)LOGF)[(qrow + (j - PAST)) * 16 + h] : 0.f); }
          att::block_scan_store<5>(v, cb, red, tid_s); }
        att::attn_small_unit<128, true>(lds, QF + qrow * FW + h * 128, FW, P.c_fk + (((size_t)l * DBATCH + b) * PAST * 16 + h) * 128, P.c_fv + (((size_t)l * DBATCH + b) * PAST * 16 + h) * 128,
                                       KF + qrow * FW + h * 128, VF + qrow * FW + h * 128, nullptr, nullptr, nullptr, GATE + qrow * DM + h * 128, OB + qrow * OP + h * 128);
        att::attn_small_unit<192, false>(lds, QN + qrow * 3072 + h * 192, 3072, nullptr, nullptr, nullptr, nullptr, KVS + (size_t)b * SKV * 4096 + h * 256, KPES + (size_t)b * SKV * 64,
                                        KVS + (size_t)b * SKV * 4096 + h * 256 + 128, GATE + qrow * DM + 2048 + h * 128, OB + qrow * OP + 2048 + h * 128, P.g_kn + l * 128);
    }
}
__device__ __forceinline__ void att_prompt_units(const Frame& F0, const Params& P, int l) {
    PHASE_FRAME(F0);
    unsigned char* ws = opaque_ptr(P.ws); LAS char* lds = (LAS char*)F.lds;
    LAS float* cb = (LAS float*)(lds + att::CB_OFF); LAS float* red = (LAS float*)(lds + att::RED_OFF);
    const bf16* QF = (const bf16*)(ws + WS_QF); const bf16* KF = (const bf16*)(ws + WS_KF); const bf16* VF = (const bf16*)(ws + WS_VF);
    const bf16* GATE = (const bf16*)(ws + WS_GATE); bf16* OB = (bf16*)(ws + WS_O); const bf16* QN = (const bf16*)(ws + WS_QN);
    const bf16* KVP = (const bf16*)(ws + WS_KVP); const bf16* KVS = (const bf16*)(ws + WS_KVS); const bf16* KPEP = (const bf16*)(ws + WS_KPEP);
    const bf16* KPES = (const bf16*)(ws + WS_KPES + l * AL(SZ_KPES)); const float* LOGF = (const float*)(ws + WS_LOGF);
    for (int u = F.vcu; u < NBATCH * 16 * 4; u += F.G) { const int bh = u >> 2, s = u & 3, b = bh >> 4, h = bh & 15; const size_t row0 = (size_t)b * SEQ;
        { float v[4]; const int nk = 256 * (8 - s); const int tid_s = opaque_tid();
#pragma unroll
          for (int e = 0; e < 4; ++e) { const int j = 4 * tid_s + e; v[e] = j < nk ? ((const GAS float*)LOGF)[(row0 + j) * 16 + h] : 0.f; }
          att::block_scan_store<4>(v, cb, red, tid_s); }
#if defined(DUP_FOXBIG)
#pragma unroll 1
        for (int pass = 0; pass < 4; ++pass) { const int qb = (pass & 1) ? s : 7 - s;
#else
#pragma unroll 1
        for (int pass = 0; pass < 2; ++pass) { const int qb = pass ? s : 7 - s;
#endif
            att::attn_big_unit<128, true>(lds, QF + row0 * FW + h * 128, FW, KF + row0 * FW + h * 128, FW, nullptr, 0, VF + row0 * FW + h * 128, FW, GATE + row0 * DM + h * 128, OB + row0 * OP + h * 128, qb); }
#pragma unroll 1
        for (int pass = 0; pass < 2; ++pass) { const int qb = pass ? s : 7 - s;
            att::attn_big_unit<192, false>(lds, QN + row0 * 3072 + h * 192, 3072, KVP + row0 * 4096 + h * 256, 4096, KPEP + row0 * 64, 64, KVP + row0 * 4096 + h * 256 + 128, 4096,
                                          GATE + row0 * DM + 2048 + h * 128, OB + row0 * OP + 2048 + h * 128, qb); }
    }
}
__device__ PH_ATTR void attention_phase(const Frame& F0, const Params& P, int l) {
    if ((F0.vcu & 1) == 0) att_sample_units(F0, P, l);
    att_prompt_units(F0, P, l);
    if ((F0.vcu & 1) != 0) att_sample_units(F0, P, l);
}

#ifndef MK_SPLIT
#define MK_SPLIT 0
#endif
__global__ void __launch_bounds__(512, 2) fwd_kernel(Params P) {
    extern __shared__ __attribute__((aligned(16))) unsigned char lds_raw[];
    Frame F; F.lds = (LAS unsigned char*)lds_raw; F.tid = threadIdx.x; F.lane = F.tid & 63; F.wave = __builtin_amdgcn_readfirstlane(F.tid >> 6);
    F.G = gridDim.x; { const int bx = blockIdx.x; F.vcu = (F.G % 8 == 0) ? (bx % 8) * (F.G / 8) + bx / 8 : bx; }
    volatile LAS unsigned* MISC = (volatile LAS unsigned*)(F.lds + MISC_OFF);
    if (F.tid < 64) MISC[F.tid] = 0u;
    __syncthreads();
#if MK_SPLIT
    const int lo = P.lo, hi = P.hi;
#define IN(k) (lo <= (k) && (k) < hi)
#define SEAM(k) do { } while (0)
#else
    xcd_barrier_post((unsigned*)(P.ws + WS_CTL) + CW_BAR);
#define IN(k) true
#define SEAM(k) xcd_barrier((unsigned*)(P.ws + WS_CTL) + CW_BAR, MISC + 8)
#endif
    LAS float* X = (LAS float*)(F.lds + XCH_OFF);
    if (IN(0)) {
#ifndef NO_P0
        convert_work<0>(F, P);
#endif
    }
    SEAM(0);
#ifdef EXP_NOLOOP
    for (int l = 0; l < 1; ++l) {
#else
#pragma unroll 1
    for (int l = 0; l < DEPTH; ++l) {
#endif
        const int pb = 1 + 5 * l; (void)pb;
        unsigned char* ws = opaque_ptr(P.ws);
        if (IN(pb)) {
#ifndef NO_G1
            const bf16* H = (const bf16*)(ws + WS_H); const bf16* W = (const bf16*)(ws + WS_WIN + l * AL(SZ_WIN));
            { pg8::Epi1qk E{P, l, X}; pg8::gemm_phase<MA, 4096, DM, HP, WP, 0, 1, pg8::WG1>(F.lds, H, W, E); }
            if (l == 0 && (blockIdx.x & 1) == 0) { convert_work<1>(F, P); __syncthreads(); }
            { pg8::Epi1vg E{P, l}; pg8::gemm_phase<MA, 6144, DM, HP, WP, 33 * 16, 1, pg8::WG1>(F.lds, H, W + (size_t)4096 * WP, E); }
            if (l == 0 && (blockIdx.x & 1) != 0) { convert_work<1>(F, P); __syncthreads(); }
            { pg8::Epi1c E{P, l}; pg8::gemm_phase<MA, 1536, DM, HP, WP, 33 * 40, 1, pg8::WG1>(F.lds, H, W + (size_t)10240 * WP, E); }

#endif
        }
        SEAM(pb);
        if (IN(pb + 1)) {
#ifndef NO_SIDE
            mid_side_jobs(F, P, l);
#if defined(DUP_SIDE)
            { const int bx = (int)blockIdx.x;
      if (F.G == 256) { skinny_item(F, P, l, bx); if (bx >= 248) skinny_item(F, P, l, 256 + bx - 248); }
      else for (int it = bx; it < MA / 32; it += F.G) skinny_item(F, P, l, it); }
#endif
#endif
#ifndef NO_G2
            { pg8::Epi2a E{P, l, X}; pg8::gemm_phase<MA, 3072, QL, QL, QL, 0, 1, pg8::WG2>(F.lds, (const bf16*)(ws + WS_CQG), (const bf16*)(ws + WS_WQB + l * AL(SZ_WQB)), E); }
            { pg8::Epi2k E{P, l, X}; pg8::gemm_phase<MA, 4096, KVL, KVL, KVL, 33 * 12, 1, pg8::WG2>(F.lds, (const bf16*)(ws + WS_CKVA + l * AL(SZ_CKVA)), (const bf16*)(ws + WS_WKVB + l * AL(SZ_WKVB)), E); }
            { pg8::Epi2c E{P, l}; pg8::gemm_phase<DBATCH * PAST, 4096, KVL, KVL, KVL, 33 * 12 + 33 * 16, 1, pg8::WG2C>(F.lds, (const bf16*)(ws + WS_CKVA + l * AL(SZ_CKVA)) + (size_t)MA * KVL, (const bf16*)(ws + WS_WKVB + l * AL(SZ_WKVB)), E); }

#endif
        }
        SEAM(pb + 1);
        if (IN(pb + 2)) {
#ifndef NO_ATT
            attention_phase(F, P, l);
#if defined(DUP_ATT)
            __syncthreads(); attention_phase(F, P, l);
#endif
#endif
        }
        SEAM(pb + 2);
        if (IN(pb + 3)) {
#ifndef NO_G3
            { pg8::Epi3 E{P, l, false}; pg8::gemm_phase<MP, DM, DM, OP, WP, 0, 1, pg8::WG3>(F.lds, (const bf16*)(ws + WS_O), (const bf16*)(ws + WS_WOUT + l * AL(SZ_WOUT)), E); }
#if defined(DUP_G3)
            { pg8::Epi3 E{P, l, true}; pg8::gemm_phase<MP, DM, DM, OP, WP, 0, 1, pg8::WG3>(F.lds, (const bf16*)(ws + WS_O), (const bf16*)(ws + WS_WOUT + l * AL(SZ_WOUT)), E); }
#endif
#ifndef EXP_NOSPLITK
            { pg8::Epi3s E{P, l}; pg8::gemm_phase<MS, DM, 256, OP, WP, 512, 16, pg8::WG3>(F.lds, (const bf16*)(ws + WS_O) + (size_t)MP * OP, (const bf16*)(ws + WS_WOUT + l * AL(SZ_WOUT)), E); }
#endif
#endif
        }
        SEAM(pb + 3);
        if (IN(pb + 4)) fin_phase(F, P, l);
        if (l == 0) SEAM(pb + 4);
    }
#undef IN
#undef SEAM
}

extern "C" void kernel_launch(void* const* d_in, const int* in_sizes, int n_in, void* d_out, int out_size, void* d_ws, size_t ws_size, hipStream_t stream) {
    static int grid = 0;
    if (grid == 0) {
        if (n_in != 21 || (size_t)out_size != O_END || ws_size < WS_END) { fprintf(stderr, "kernel_launch: unexpected shapes (n_in %d, out %d, ws %zu; need 21, %zu, >= %zu)\n", n_in, out_size, ws_size, (size_t)O_END, (size_t)WS_END); grid = -1; return; }
        int dev = 0, cus = 0, per_cu = 0;
        if (hipGetDevice(&dev) != hipSuccess || hipDeviceGetAttribute(&cus, hipDeviceAttributeMultiprocessorCount, dev) != hipSuccess) { grid = -1; return; }
        if (hipFuncSetAttribute((const void*)fwd_kernel, hipFuncAttributeMaxDynamicSharedMemorySize, LDS_BYTES) != hipSuccess) { fprintf(stderr, "kernel_launch: hipFuncSetAttribute failed\n"); grid = -1; return; }
        if (hipOccupancyMaxActiveBlocksPerMultiprocessor(&per_cu, (const void*)fwd_kernel, 512, LDS_BYTES) != hipSuccess || per_cu < 1) fprintf(stderr, "kernel_launch: occupancy query says %d\n", per_cu);
        (void)hipGetLastError();
        grid = cus;
    }
    if (grid < 0) return;
    if (hipMemsetAsync((char*)d_ws + WS_CTL, 0, CTL_BYTES, stream) != hipSuccess) return;
    Params p{};
    const float** pf = (const float**)&p;
    for (int i = 0; i < 21; ++i) pf[i] = (const float*)d_in[i];
    p.out = (float*)d_out; p.ws = (unsigned char*)d_ws;
#if MK_SPLIT
    for (int ph = 0; ph <= 10; ++ph) { if (ph == 10) continue; p.lo = ph; p.hi = ph + 1; hipLaunchKernelGGL(fwd_kernel, dim3(grid), dim3(512), LDS_BYTES, stream, p); }
#else
    p.lo = 0; p.hi = 11;
    hipLaunchKernelGGL(fwd_kernel, dim3(grid), dim3(512), LDS_BYTES, stream, p);
#endif
}
```

```cpp
#include <hip/hip_runtime.h>
#include <cstdio>
#include <cstdint>

#define GAS __attribute__((address_space(1)))
#define LAS __attribute__((address_space(3)))
typedef unsigned short bf16;
typedef short bf16x8 __attribute__((ext_vector_type(8)));
typedef short s16x4 __attribute__((ext_vector_type(4)));
typedef float f32x2 __attribute__((ext_vector_type(2)));
typedef float f32x4 __attribute__((ext_vector_type(4)));
typedef float f32x16 __attribute__((ext_vector_type(16)));
typedef unsigned u32x2 __attribute__((ext_vector_type(2)));
typedef unsigned u32x4 __attribute__((ext_vector_type(4)));

constexpr int DM = 4096, NBATCH = 4, SEQ = 2048, DEPTH = 2, DBATCH = 16, DSEQ = 16, PAST = 2048;
constexpr int MP = NBATCH * SEQ, MS = DBATCH * DSEQ, MA = MP + MS;
constexpr int FW = 2048, QL = 1024, KVL = 512, ROPE = 64, NIN = 11856;
constexpr int N1 = 11776;
constexpr int SKV = PAST + DSEQ;
constexpr int KVS_ROWS = DBATCH * SKV;
constexpr int CKVA_ROWS = MA + DBATCH * PAST;
#ifndef PADK
#define PADK 0
#endif
constexpr int HP = DM + PADK, WP = DM + PADK, OP = DM + PADK;
constexpr float EPS = 1e-6f;
constexpr float LOG2E = 1.4426950408889634f;
constexpr float FOX_C2 = 0.08838834764831845f * LOG2E;
constexpr float MLA_C2 = 0.07216878364870322f * LOG2E;

constexpr size_t MiB = 1u << 20;
constexpr size_t AL(size_t x) { return (x + 255) & ~(size_t)255; }
constexpr size_t WS_CTL = 0, CTL_BYTES = 2 * MiB;
constexpr size_t SZ_WIN = (size_t)N1 * WP * 2, SZ_W80 = (size_t)96 * DM * 2, SZ_WQB = (size_t)3072 * QL * 2, SZ_WKVB = (size_t)4096 * KVL * 2, SZ_WOUT = (size_t)DM * WP * 2;
constexpr size_t WS_WIN = CTL_BYTES;
constexpr size_t WS_W80 = WS_WIN + 2 * AL(SZ_WIN);
constexpr size_t WS_WQB = WS_W80 + 2 * AL(SZ_W80);
constexpr size_t WS_WKVB = WS_WQB + 2 * AL(SZ_WQB);
constexpr size_t WS_WOUT = WS_WKVB + 2 * AL(SZ_WKVB);
constexpr size_t WS_H = WS_WOUT + 2 * AL(SZ_WOUT);
constexpr size_t WS_QF = WS_H + AL((size_t)MA * HP * 2);
constexpr size_t WS_KF = WS_QF + AL((size_t)MA * FW * 2);
constexpr size_t WS_VF = WS_KF + AL((size_t)MA * FW * 2);
constexpr size_t WS_GATE = WS_VF + AL((size_t)MA * FW * 2);
constexpr size_t WS_CQG = WS_GATE + AL((size_t)MA * DM * 2);
constexpr size_t SZ_CKVA = (size_t)CKVA_ROWS * KVL * 2;
constexpr size_t WS_CKVA = WS_CQG + AL((size_t)MA * QL * 2);
constexpr size_t WS_QN = WS_CKVA + 2 * AL(SZ_CKVA);
constexpr size_t WS_KVP = WS_QN + AL((size_t)MA * 3072 * 2);
constexpr size_t WS_KVS = WS_KVP + AL((size_t)MP * 4096 * 2);
constexpr size_t WS_KPEP = WS_KVS + AL((size_t)(KVS_ROWS + 128) * 4096 * 2);
constexpr size_t SZ_KPES = (size_t)(KVS_ROWS + 128) * 64 * 2;
constexpr size_t WS_KPES = WS_KPEP + AL((size_t)MP * 64 * 2);
constexpr size_t WS_LOGF = WS_KPES + 2 * AL(SZ_KPES);
constexpr size_t WS_O = WS_LOGF + AL((size_t)MA * 16 * 4);
constexpr size_t WS_Y0 = WS_O + AL((size_t)MA * OP * 2);
constexpr size_t WS_ROPE = WS_Y0 + AL((size_t)MA * DM * 4);
constexpr size_t WS_SLAB = WS_ROPE + AL((size_t)SKV * 32 * 2 * 4);
constexpr size_t WS_END = WS_SLAB + (size_t)16 * MS * DM * 4;
constexpr int CW_BAR = 4096;
constexpr int CW_SSQH = 16384;
constexpr int CW_SSQCQ = CW_SSQH + 2 * MA;
constexpr int CW_SSQCKV = CW_SSQCQ + 2 * MA;
static_assert((CW_SSQCKV + 2 * MA) * 4 <= (int)CTL_BYTES, "ctl");
constexpr size_t O_YP = 0, O_YS = O_YP + (size_t)MP * DM, O_FKP = O_YS + (size_t)MS * DM, O_FVP = O_FKP + (size_t)2 * MP * FW, O_FLP = O_FVP + (size_t)2 * MP * FW,
                 O_CKVP = O_FLP + (size_t)2 * MP * 16, O_KPEP = O_CKVP + (size_t)2 * MP * KVL, O_FKS = O_KPEP + (size_t)2 * MP * ROPE, O_FVS = O_FKS + (size_t)2 * MS * FW,
                 O_FLS = O_FVS + (size_t)2 * MS * FW, O_CKVS = O_FLS + (size_t)2 * MS * 16, O_KPES = O_CKVS + (size_t)2 * MS * KVL, O_END = O_KPES + (size_t)2 * MS * ROPE;

constexpr int RING_BYTES = 131072;
constexpr int XCH_OFF = RING_BYTES;
constexpr int MISC_OFF = XCH_OFF + 16384;
constexpr int LDS_BYTES = MISC_OFF + 256;

struct Params {
    const float *x_p, *x_s, *c_fk, *c_fv, *c_fl, *c_ckv, *c_kpe, *g_norm, *w_in, *b_f, *g_qf, *g_kf, *g_cq, *w_qb, *g_qn, *g_qp, *g_ckv, *g_kp, *w_kvb, *g_kn, *w_out;
    float* out; unsigned char* ws; int lo, hi;
};

#define LDS_WAIT() asm volatile("s_waitcnt lgkmcnt(0)" ::: "memory")
#define VM_WAIT() asm volatile("s_waitcnt vmcnt(0)" ::: "memory")
#define SBAR() __builtin_amdgcn_sched_barrier(0)
__device__ __forceinline__ unsigned cvtpk(float lo, float hi) { unsigned r; asm volatile("v_cvt_pk_bf16_f32 %0, %1, %2" : "=v"(r) : "v"(lo), "v"(hi)); return r; }
__device__ __forceinline__ bf16x8 pack8(f32x4 a, f32x4 b) { u32x4 w = {cvtpk(a[0], a[1]), cvtpk(a[2], a[3]), cvtpk(b[0], b[1]), cvtpk(b[2], b[3])}; return __builtin_bit_cast(bf16x8, w); }
__device__ __forceinline__ float bf2f(unsigned short b) { return __uint_as_float(((unsigned)b) << 16); }
#define swz_xor(v, pat) __int_as_float(__builtin_amdgcn_ds_swizzle(__float_as_int(v), pat))
#define SWZ_X1 0x041F
#define SWZ_X2 0x081F
#define SWZ_X4 0x101F
#define SWZ_X8 0x201F
#define SWZ_X16 0x401F
__device__ __forceinline__ float xor16(float v) { return __int_as_float(__builtin_amdgcn_ds_swizzle(__float_as_int(v), SWZ_X16)); }
__device__ __forceinline__ float sum32(float v) { auto r = __builtin_amdgcn_permlane32_swap(__float_as_uint(v), __float_as_uint(v), false, false); return __uint_as_float(r[0]) + __uint_as_float(r[1]); }
__device__ __forceinline__ float max32(float v) { auto r = __builtin_amdgcn_permlane32_swap(__float_as_uint(v), __float_as_uint(v), false, false); return fmaxf(__uint_as_float(r[0]), __uint_as_float(r[1])); }
__device__ __forceinline__ float wave_sum(float v) {
    v += __int_as_float(__builtin_amdgcn_ds_swizzle(__float_as_int(v), SWZ_X1)); v += __int_as_float(__builtin_amdgcn_ds_swizzle(__float_as_int(v), SWZ_X2));
    v += __int_as_float(__builtin_amdgcn_ds_swizzle(__float_as_int(v), SWZ_X4)); v += __int_as_float(__builtin_amdgcn_ds_swizzle(__float_as_int(v), SWZ_X8));
    v += xor16(v); return sum32(v);
}
__device__ __forceinline__ int opaque_tid() { int t = threadIdx.x; asm volatile("" : "+v"(t)); return t; }
template <class T> __device__ __forceinline__ T* opaque_ptr(T* p) { asm volatile("" : "+s"(p)); return (T*)(GAS T*)p; }
__device__ __forceinline__ float silu_f(float v) { return v * __builtin_amdgcn_rcpf(1.0f + __expf(-v)); }
__device__ __forceinline__ void atomic_addf(float* p, float v) { (void)__hip_atomic_fetch_add((GAS float*)p, v, __ATOMIC_RELAXED, __HIP_MEMORY_SCOPE_AGENT); }

#define XB_TMO      128
#define XB_XCNT(j)  (256  + 64 * (j))
#define XB_XSUB(j)  (1280 + 64 * (j))
#define XB_XGEN(j)  (2304 + 64 * (j))
#define XB_TOP      3328
#define XB_TOPGEN   3392
#define XCD_BAR_WORDS 3456
#define XB_SPIN_CAP (1u << 20)
__device__ __forceinline__ unsigned xb_ld(unsigned* p)              { return __hip_atomic_load(p, __ATOMIC_RELAXED, __HIP_MEMORY_SCOPE_AGENT); }
__device__ __forceinline__ unsigned xb_add(unsigned* p, unsigned v) { return __hip_atomic_fetch_add(p, v, __ATOMIC_RELAXED, __HIP_MEMORY_SCOPE_AGENT); }
__device__ __forceinline__ unsigned xb_xcc_id() { return (unsigned)__builtin_amdgcn_s_getreg((3 << 11) | 20) & 0xFu; }
#define XB_SPIN(cond, bar) do { unsigned _sp = 0; while (cond) { __builtin_amdgcn_s_sleep(1); \
    if ((++_sp & 255u) == 0u) { if (xb_ld(&(bar)[XB_TMO])) break; if (_sp > XB_SPIN_CAP) { atomicAdd(&(bar)[XB_TMO], 1u); break; } } } } while (0)
__device__ __forceinline__ void xcd_barrier_post(unsigned* bar) { if (threadIdx.x == 0) (void)xb_add(&bar[XB_XCNT(xb_xcc_id())], 1u); }
__device__ __forceinline__ void xcd_barrier_census(unsigned* bar, volatile LAS unsigned* st) {
    const unsigned G = gridDim.x * gridDim.y * gridDim.z; const unsigned x = xb_xcc_id(); const int lane = (int)threadIdx.x;
    unsigned sum, cnt, mine, sp = 0u;
    for (;;) {
        const unsigned c = lane < 16 ? xb_ld(&bar[XB_XCNT(lane)]) : 0u;
        int t = (int)c;
        t += __builtin_amdgcn_ds_swizzle(t, SWZ_X8); t += __builtin_amdgcn_ds_swizzle(t, SWZ_X4); t += __builtin_amdgcn_ds_swizzle(t, SWZ_X2); t += __builtin_amdgcn_ds_swizzle(t, SWZ_X1);
        sum = (unsigned)__builtin_amdgcn_readfirstlane(t);
        cnt = (unsigned)__builtin_popcountll(__ballot(c > 0u)); mine = (unsigned)__builtin_amdgcn_readlane((int)c, (int)x);
        if (sum == G) break;
        __builtin_amdgcn_s_sleep(1);
        if ((++sp & 255u) == 0u) { if (xb_ld(&bar[XB_TMO])) break; if (sp > XB_SPIN_CAP) { if (lane == 0) atomicAdd(&bar[XB_TMO], 1u); break; } }
    }
    if (lane == 0) { st[0] = mine > 0u ? mine : 1u; st[1] = cnt > 0u ? cnt : 1u; }
}
__device__ __forceinline__ void xcd_barrier(unsigned* bar, volatile LAS unsigned* st) {
    asm volatile("s_waitcnt vmcnt(0)" ::: "memory");
    __syncthreads();
    if (threadIdx.x < 64) {
        if (st[0] == 0u) xcd_barrier_census(bar, st);
        asm volatile("s_waitcnt lgkmcnt(0)" ::: "memory");
    }
    if (threadIdx.x == 0) {
        const unsigned x = xb_xcc_id();
        __builtin_amdgcn_s_waitcnt(0);
        const unsigned nloc = st[0], nx = st[1];
        const unsigned old = xb_add(&bar[XB_XSUB(x)], 1u);
        const unsigned gen = old / nloc;
        if (old + 1u == (gen + 1u) * nloc) {
            __builtin_amdgcn_fence(__ATOMIC_RELEASE, "agent");
            asm volatile("s_waitcnt vmcnt(0)" ::: "memory");
            const unsigned og = xb_add(&bar[XB_TOP], 1u);
            const unsigned tg = og / nx;
            if (og + 1u == (tg + 1u) * nx) xb_add(&bar[XB_TOPGEN], 1u);
            else XB_SPIN(xb_ld(&bar[XB_TOPGEN]) == tg, bar);
            __builtin_amdgcn_fence(__ATOMIC_ACQUIRE, "agent");
            xb_add(&bar[XB_XGEN(x)], 1u);
            asm volatile("s_waitcnt vmcnt(0)" ::: "memory");
        } else {
            XB_SPIN(xb_ld(&bar[XB_XGEN(x)]) == gen, bar);
            __builtin_amdgcn_fence(__ATOMIC_ACQUIRE, "agent");
            asm volatile("s_waitcnt vmcnt(0)" ::: "memory");
        }
    }
    __syncthreads();
}

namespace pg8 {
constexpr int BM = 256, BK = 64, HALF = 128, HTB = HALF * BK * 2, STAGE_BYTES = 8 * HTB, NXCD = 8, WG1 = 105, WG2 = 105, WG2C = 108, WG3 = 105;
__host__ __device__ __forceinline__ int lds_byte(int r, int c) { const int st = (r >> 4) * 2 + (c >> 5), rr = r & 15, cc = c & 31, ob = rr * 64 + cc * 2; return st * 1024 + (ob ^ (((ob >> 9) & 1) << 5)); }
__host__ __device__ __forceinline__ void stage_rc(int b, int& R, int& C) { const int st = b / 1024, sb = b % 1024, swz = sb ^ (((sb >> 9) & 1) << 5); R = (st >> 1) * 16 + swz / 64; C = (st & 1) * 32 + (swz % 64) / 2; }
__host__ __device__ __forceinline__ int perm32(int rho) { const int n = rho >> 4, i = rho & 15; return 8 * (i >> 2) + 4 * n + (i & 3); }
struct Unit { int pm, pn, ko; };
template <int NM, int NN, int BASE, int SPLITS, int K, int WGM>
struct Order {
    int G, c, i0;
    __device__ __forceinline__ void init(int G_, int c_) { G = G_; c = c_; i0 = BASE <= c_ ? 0 : (BASE - c_ + G_ - 1) / G_; }
    __device__ __forceinline__ bool next(int i, Unit& u) const {
        constexpr int nwg = NM * NN * SPLITS;
        const int L = (i0 + i) * G + c - BASE; if (L >= nwg) return false;
        if constexpr (SPLITS > 1) { u.pm = 0; u.pn = L % NN; u.ko = (L / NN) * K; }
        else { int wgid = L; { constexpr int q = nwg / NXCD, r = nwg % NXCD; const int xcd = wgid % NXCD, off = wgid / NXCD; wgid = (xcd < r ? xcd * (q + 1) : r * (q + 1) + (xcd - r) * q) + off; }
            constexpr int WG = WGM % 100; constexpr bool ROT = WGM >= 100;
            constexpr int nig = WG * NN; const int gid = wgid / nig, fm = gid * WG, gsz = (NM - fm) < WG ? (NM - fm) : WG;
            u.pm = fm + ((wgid % nig) % gsz); u.pn = (wgid % nig) / gsz; u.ko = 0;
            if constexpr (ROT) { u.pn += (((fm * 8) / NM) * NN) / 8; if (u.pn >= NN) u.pn -= NN; } }
        return true;
    }
};

typedef f32x4 Acc[2][2][4][2];

template <int M, int N, int K, int LDA, int LDB, int BASE, int SPLITS, int WGM, class Epi>
__device__ __forceinline__ void gemm_phase(LAS unsigned char* lds, const bf16* gA, const bf16* gBt, const Epi& E) {
    int g_ = (int)gridDim.x, c_ = (int)blockIdx.x; asm volatile("" : "+s"(g_), "+s"(c_));
    Order<M / BM, N / BM, BASE, SPLITS, K, WGM> S; S.init(g_, c_);
    int tid_ = threadIdx.x; asm volatile("" : "+v"(tid_));
    const int tid = tid_, wid = __builtin_amdgcn_readfirstlane(tid >> 6), lane = tid & 63, wr = wid >> 2, wc = wid & 3, fr = lane & 15, fq = lane >> 4;
    constexpr int nt = K / BK;
    unsigned voffA[2], voffB[2];
#pragma unroll
    for (int i = 0; i < 2; ++i) { int R, C; stage_rc(tid * 16 + i * 8192, R, C); const int Rb = (R & ~31) + perm32(R & 31);
        voffA[i] = (unsigned)(R * LDA + C) * 2u; voffB[i] = (unsigned)(Rb * LDB + C) * 2u; }
    constexpr size_t kstep = (size_t)(BK * 2);
    constexpr size_t hstepA = (size_t)HALF * LDA * 2, hstepB = (size_t)HALF * LDB * 2;
    constexpr size_t tstepA = 2 * hstepA, tstepB = 2 * hstepB;
    const unsigned ldsw = (unsigned)wid * 1024u;
    const int aoff = lds_byte(wr * 64 + fr, fq * 8), boff = lds_byte(wc * 32 + fr, fq * 8);
#define PG8_SA(b, h) (((b) * 2 + (h)) * HTB)
#define PG8_SB(b, h) ((4 + (b) * 2 + (h)) * HTB)
#define PG8_STAGE(bufoff, gbase, voff) do { _Pragma("unroll") for (int _i = 0; _i < 2; ++_i) \
        __builtin_amdgcn_global_load_lds((const unsigned*)((const char*)(gbase) + (voff)[_i]), (LAS unsigned*)(lds + (bufoff) + ldsw + _i * 8192), 16, 0, 1); } while (0)
#define PG8_LDA(dst, b, h) do { _Pragma("unroll") for (int m = 0; m < 4; ++m) _Pragma("unroll") for (int k = 0; k < 2; ++k) dst[m][k] = *(const LAS bf16x8*)(lds + PG8_SA(b, h) + aoff + m * 2048 + k * 1024); } while (0)
#define PG8_LDB(dst, b, h) do { _Pragma("unroll") for (int n = 0; n < 2; ++n) _Pragma("unroll") for (int k = 0; k < 2; ++k) dst[n][k] = *(const LAS bf16x8*)(lds + PG8_SB(b, h) + boff + n * 2048 + k * 1024); } while (0)
#define PG8_MMA(ai, bj, At, Bt) do { __builtin_amdgcn_s_setprio(1); _Pragma("unroll") for (int m = 0; m < 4; ++m) _Pragma("unroll") for (int n = 0; n < 2; ++n) _Pragma("unroll") for (int k = 0; k < 2; ++k) \
        acc[ai][bj][m][n] = __builtin_amdgcn_mfma_f32_16x16x32_bf16(Bt[n][k], At[m][k], acc[ai][bj][m][n], 0, 0, 0); __builtin_amdgcn_s_setprio(0); } while (0)
#define PG8_WAIT_V(n) asm volatile("s_waitcnt vmcnt(" #n ")" ::: "memory")
#define PG8_WAIT_L(n) asm volatile("s_waitcnt lgkmcnt(" #n ")" ::: "memory")
#define PG8_BAR __builtin_amdgcn_s_barrier()
#define PG8_SCHED __builtin_amdgcn_sched_barrier(0)
    Unit cur, nxt; int ui = 0;
    if (!S.next(0, cur)) return;
    Acc acc;
#pragma unroll
    for (int a = 0; a < 2; ++a)
#pragma unroll
        for (int b = 0; b < 2; ++b)
#pragma unroll
            for (int m = 0; m < 4; ++m)
#pragma unroll
                for (int n = 0; n < 2; ++n) acc[a][b][m][n] = (f32x4){0.f, 0.f, 0.f, 0.f};
    bf16x8 At[4][2], B0[2][2], B1[2][2];
    const char* cA = (const char*)gA + (size_t)cur.pm * tstepA + (size_t)cur.ko * 2; const char* cB = (const char*)gBt + (size_t)cur.pn * tstepB + (size_t)cur.ko * 2;
    PG8_STAGE(PG8_SB(0, 0), cB, voffB); PG8_STAGE(PG8_SB(0, 1), cB + hstepB, voffB); PG8_STAGE(PG8_SA(0, 0), cA, voffA); PG8_STAGE(PG8_SA(0, 1), cA + hstepA, voffA);
    if (wr == 1) PG8_BAR;
    PG8_WAIT_V(2); PG8_BAR;
    PG8_STAGE(PG8_SB(1, 0), cB + kstep, voffB); PG8_STAGE(PG8_SA(1, 0), cA + kstep, voffA); PG8_STAGE(PG8_SB(1, 1), cB + hstepB + kstep, voffB);
    PG8_WAIT_V(6); PG8_BAR;
    for (;;) {
        const bool has_next = S.next(ui + 1, nxt);
        const char* nA = has_next ? (const char*)gA + (size_t)nxt.pm * tstepA + (size_t)nxt.ko * 2 : cA; const char* nB = has_next ? (const char*)gBt + (size_t)nxt.pn * tstepB + (size_t)nxt.ko * 2 : cB;
        for (int t = 0; t < nt; t += 2) {
            const bool last = (t == nt - 2);
            const char* a1 = cA + (size_t)(t + 1) * kstep;
            const char* a2 = last ? nA : cA + (size_t)(t + 2) * kstep; const char* b2 = last ? nB : cB + (size_t)(t + 2) * kstep;
            const char* a3 = a2 + kstep; const char* b3 = b2 + kstep;
            asm volatile("" : "+s"(a1), "+s"(a2), "+s"(b2), "+s"(a3), "+s"(b3));
            PG8_LDB(B0, 0, 0); PG8_LDB(B1, 0, 1); PG8_SCHED; PG8_LDA(At, 0, 0); PG8_STAGE(PG8_SA(1, 1), a1 + hstepA, voffA);
            PG8_WAIT_V(8); PG8_WAIT_L(0); PG8_BAR; PG8_MMA(0, 0, At, B0); PG8_MMA(0, 1, At, B1); PG8_BAR; PG8_SCHED;
            PG8_LDA(At, 0, 1); PG8_STAGE(PG8_SB(0, 0), b2, voffB); PG8_STAGE(PG8_SB(0, 1), b2 + hstepB, voffB); PG8_STAGE(PG8_SA(0, 0), a2, voffA);
            PG8_WAIT_V(8); PG8_WAIT_L(0); PG8_BAR; PG8_MMA(1, 0, At, B0); PG8_MMA(1, 1, At, B1); PG8_BAR; PG8_SCHED;
            PG8_LDB(B0, 1, 0); PG8_LDB(B1, 1, 1); PG8_SCHED; PG8_LDA(At, 1, 0); PG8_STAGE(PG8_SA(0, 1), a2 + hstepA, voffA);
            PG8_WAIT_V(8); PG8_WAIT_L(0); PG8_BAR; PG8_MMA(0, 0, At, B0); PG8_MMA(0, 1, At, B1); PG8_BAR; PG8_SCHED;
            PG8_LDA(At, 1, 1); PG8_STAGE(PG8_SB(1, 0), b3, voffB); PG8_STAGE(PG8_SB(1, 1), b3 + hstepB, voffB); PG8_STAGE(PG8_SA(1, 0), a3, voffA);
            PG8_WAIT_V(8); PG8_WAIT_L(0); PG8_BAR; PG8_MMA(1, 0, At, B0); PG8_MMA(1, 1, At, B1); PG8_BAR; PG8_SCHED;
        }
        if constexpr (Epi::SYNC) { if (wr == 0) PG8_BAR; }
        { const int t2 = opaque_tid();
          E(acc, cur, wr, wc, t2 & 15, (t2 >> 4) & 3, ui); }
        if (!has_next) break;
#pragma unroll
        for (int a = 0; a < 2; ++a)
#pragma unroll
            for (int b = 0; b < 2; ++b)
#pragma unroll
                for (int m = 0; m < 4; ++m)
#pragma unroll
                    for (int n = 0; n < 2; ++n) acc[a][b][m][n] = (f32x4){0.f, 0.f, 0.f, 0.f};
        cur = nxt; cA = nA; cB = nB; ++ui;
        if constexpr (Epi::SYNC) { if (wr == 1) PG8_BAR; }
    }
    PG8_WAIT_V(0);
    if constexpr (!Epi::SYNC) { if (wr == 0) PG8_BAR; }
    PG8_BAR;
#undef PG8_SA
#undef PG8_SB
#undef PG8_STAGE
#undef PG8_LDA
#undef PG8_LDB
#undef PG8_MMA
#undef PG8_WAIT_V
#undef PG8_WAIT_L
#undef PG8_BAR
#undef PG8_SCHED
}

#define FOR_AM _Pragma("unroll") for (int ai = 0; ai < 2; ++ai) _Pragma("unroll") for (int m = 0; m < 4; ++m)
#define FOR_BN _Pragma("unroll") for (int bj = 0; bj < 2; ++bj) _Pragma("unroll") for (int n = 0; n < 2; ++n)
__device__ __forceinline__ void part_ss(const Acc& acc, float (&ss)[2][4][2]) {
    FOR_AM {
#pragma unroll
        for (int bj = 0; bj < 2; ++bj) { const f32x4 a = acc[ai][bj][m][0], b = acc[ai][bj][m][1];
            float s = (a[0] * a[0] + a[1] * a[1]) + (a[2] * a[2] + a[3] * a[3]) + (b[0] * b[0] + b[1] * b[1]) + (b[2] * b[2] + b[3] * b[3]);
            s += xor16(s); s = sum32(s); ss[ai][m][bj] = s; } }
}
__device__ __forceinline__ void xchg_ss(const float (&ss)[2][4][2], LAS float* X, int wr, int wc, int fr, int fq) {
    if (fq == 0) { FOR_AM {
#pragma unroll
        for (int bj = 0; bj < 2; ++bj) X[((ai * 128 + wr * 64 + m * 16 + fr) * 2 + bj) * 4 + wc] = ss[ai][m][bj]; } }
    asm volatile("s_waitcnt lgkmcnt(0)" ::: "memory"); __builtin_amdgcn_s_barrier(); asm volatile("" ::: "memory");
}
__device__ __forceinline__ f32x4 xrd(const LAS float* X, int rloc, int bj) { return *(const LAS f32x4*)(X + (rloc * 2 + bj) * 4); }
__device__ __forceinline__ void row_scale(Acc& acc, const float* ssq, float invk, int row0) {
    FOR_AM { const float rs = rsqrtf(((const GAS float*)ssq)[row0 + ai * 128 + m * 16] * invk + EPS);
        FOR_BN acc[ai][bj][m][n] *= rs; }
}
__device__ __forceinline__ u32x4 pk8(const f32x4 a, const f32x4 b) { u32x4 w = {cvtpk(a[0], a[1]), cvtpk(a[2], a[3]), cvtpk(b[0], b[1]), cvtpk(b[2], b[3])}; return w; }
template <bool NT = false>
__device__ __forceinline__ void store_bf16(const Acc& acc, bf16* base, size_t pitch, int row0, int col0) {
    FOR_AM { bf16* rp = base + (size_t)(row0 + ai * 128 + m * 16) * pitch + col0;
#pragma unroll
        for (int bj = 0; bj < 2; ++bj) { const u32x4 w_ = pk8(acc[ai][bj][m][0], acc[ai][bj][m][1]);
            if (NT) __builtin_nontemporal_store(w_, (GAS u32x4*)(rp + bj * 128)); else *(GAS u32x4*)(rp + bj * 128) = w_; }
        asm volatile("" ::: "memory"); }
}
template <bool NT = false>
__device__ __forceinline__ void store_f32(const Acc& acc, float* base, size_t pitch, int row0, int col0) {
    FOR_AM { float* rp = base + (size_t)(row0 + ai * 128 + m * 16) * pitch + col0;
#pragma unroll
        for (int bj = 0; bj < 2; ++bj) {
            if (NT) { __builtin_nontemporal_store(acc[ai][bj][m][0], (GAS f32x4*)(rp + bj * 128)); __builtin_nontemporal_store(acc[ai][bj][m][1], (GAS f32x4*)(rp + bj * 128 + 4)); }
            else { *(GAS f32x4*)(rp + bj * 128) = acc[ai][bj][m][0]; *(GAS f32x4*)(rp + bj * 128 + 4) = acc[ai][bj][m][1]; } }
        asm volatile("" ::: "memory"); }
}

struct Epi1qk {
    static constexpr bool SYNC = true;
    const Params& P; int l; LAS float* X;
    __device__ __forceinline__ void operator()(Acc& acc, const Unit& u, int wr, int wc, int fr, int fq, int ui) const {
        unsigned char* ws = opaque_ptr(P.ws); float* ctl = (float*)(ws + WS_CTL);
        const int pn = u.pn, row0 = u.pm * BM + wr * 64 + fr, cl = wc * 32 + 8 * fq;
        const bool smp = u.pm >= MP / BM; const int rowo = smp ? row0 - MP : row0;
        row_scale(acc, ctl + CW_SSQH + l * MA, 1.0f / DM, row0);
        { float ss[2][4][2]; part_ss(acc, ss); xchg_ss(ss, X + (ui & 1) * 2048, wr, wc, fr, fq); }
        const bool isk = pn >= 8; const int colh = (pn & 7) * 256 + cl;
        const float* gp = (isk ? P.g_kf : P.g_qf) + l * 128 + cl; const f32x4 g0 = *(const GAS f32x4*)gp, g1 = *(const GAS f32x4*)(gp + 4);
        bf16* bb = (bf16*)(ws + (isk ? WS_KF : WS_QF)); float* fo = P.out + (smp ? O_FKS + (size_t)l * MS * FW : O_FKP + (size_t)l * MP * FW);
        FOR_AM { const int rloc = ai * 128 + wr * 64 + m * 16 + fr;
#pragma unroll
            for (int bj = 0; bj < 2; ++bj) { const f32x4 t = xrd(X + (ui & 1) * 2048, rloc, bj); const float rn = rsqrtf(((t[0] + t[1]) + (t[2] + t[3])) * (1.0f / 128) + EPS);
                const f32x4 a = acc[ai][bj][m][0] * rn * g0, b = acc[ai][bj][m][1] * rn * g1;
                __builtin_nontemporal_store(pk8(a, b), (GAS u32x4*)(bb + (size_t)(row0 + ai * 128 + m * 16) * FW + colh + bj * 128));
                if (isk) { float* rp = fo + (size_t)(rowo + ai * 128 + m * 16) * FW + colh + bj * 128; __builtin_nontemporal_store(a, (GAS f32x4*)rp); __builtin_nontemporal_store(b, (GAS f32x4*)(rp + 4)); } }
            asm volatile("" ::: "memory"); }
    }
};
struct Epi1vg {
    static constexpr bool SYNC = false;
    const Params& P; int l;
    __device__ __forceinline__ void operator()(Acc& acc, const Unit& u, int wr, int wc, int fr, int fq, int ui) const {
        unsigned char* ws = opaque_ptr(P.ws);
        const int pn = u.pn, row0 = u.pm * BM + wr * 64 + fr, cl = wc * 32 + 8 * fq;
        row_scale(acc, (const float*)(ws + WS_CTL) + CW_SSQH + l * MA, 1.0f / DM, row0);
        if (pn < 8) {
            const bool smp = u.pm >= MP / BM; const int rowo = smp ? row0 - MP : row0; const int colh = pn * 256 + cl;
            store_bf16<true>(acc, (bf16*)(ws + WS_VF), FW, row0, colh); store_f32<true>(acc, P.out + (smp ? O_FVS + (size_t)l * MS * FW : O_FVP + (size_t)l * MP * FW), FW, rowo, colh);
        } else {
            FOR_AM { FOR_BN {
#pragma unroll
                for (int e = 0; e < 4; ++e) acc[ai][bj][m][n][e] = silu_f(acc[ai][bj][m][n][e]); } }
            store_bf16<true>(acc, (bf16*)(ws + WS_GATE), DM, row0, (pn - 8) * 256 + cl);
        }
    }
};
struct Epi1c {
    static constexpr bool SYNC = false;
    const Params& P; int l;
    __device__ __forceinline__ void operator()(Acc& acc, const Unit& u, int wr, int wc, int fr, int fq, int ui) const {
        unsigned char* ws = opaque_ptr(P.ws); float* ctl = (float*)(ws + WS_CTL);
        const int pn = u.pn, row0 = u.pm * BM + wr * 64 + fr, cl = wc * 32 + 8 * fq;
        const bool smp = u.pm >= MP / BM; const int rowo = smp ? row0 - MP : row0;
        row_scale(acc, ctl + CW_SSQH + l * MA, 1.0f / DM, row0);
        const bool isc = pn >= 4;
        { float ss[2][4][2]; part_ss(acc, ss); float* sq = ctl + (isc ? CW_SSQCKV : CW_SSQCQ) + l * MA;
          if (fq == 0) { FOR_AM atomic_addf(sq + row0 + ai * 128 + m * 16, ss[ai][m][0] + ss[ai][m][1]); } }
        const int colc = (isc ? (pn - 4) : pn) * 256 + cl;
        const float* gp = (isc ? P.g_ckv + l * KVL : P.g_cq + l * QL) + colc;
#pragma unroll
        for (int bj = 0; bj < 2; ++bj) { const f32x4 g0 = *(const GAS f32x4*)(gp + bj * 128), g1 = *(const GAS f32x4*)(gp + bj * 128 + 4);
            FOR_AM { acc[ai][bj][m][0] *= g0; acc[ai][bj][m][1] *= g1; } }
        if (isc) { store_bf16(acc, (bf16*)(ws + WS_CKVA + l * AL(SZ_CKVA)), KVL, row0, colc); store_f32(acc, P.out + (smp ? O_CKVS + (size_t)l * MS * KVL : O_CKVP + (size_t)l * MP * KVL), KVL, rowo, colc); }
        else store_bf16(acc, (bf16*)(ws + WS_CQG), QL, row0, colc);
    }
};

struct Epi2a {
    static constexpr bool SYNC = true;
    const Params& P; int l; LAS float* X;
    __device__ __forceinline__ void operator()(Acc& acc, const Unit& u, int wr, int wc, int fr, int fq, int ui) const {
        unsigned char* ws = opaque_ptr(P.ws); bf16* QN = (bf16*)(ws + WS_QN);
        const int pn = u.pn, row0 = u.pm * BM + wr * 64 + fr, cl = wc * 32 + 8 * fq;
        row_scale(acc, (const float*)(ws + WS_CTL) + CW_SSQCQ + l * MA, 1.0f / QL, row0);
        { float ss[2][4][2]; part_ss(acc, ss); xchg_ss(ss, X + (ui & 1) * 2048, wr, wc, fr, fq); }
        const LAS float* Xr = X + (ui & 1) * 2048;
        if (pn < 8) {
            const float* gp = P.g_qn + l * 128 + cl; const f32x4 g0 = *(const GAS f32x4*)gp, g1 = *(const GAS f32x4*)(gp + 4);
            FOR_AM { const int rloc = ai * 128 + wr * 64 + m * 16 + fr; bf16* rp = QN + (size_t)(row0 + ai * 128 + m * 16) * 3072 + 192 * (2 * pn) + cl;
#pragma unroll
                for (int bj = 0; bj < 2; ++bj) { const f32x4 t = xrd(Xr, rloc, bj); const float rn = rsqrtf(((t[0] + t[1]) + (t[2] + t[3])) * (1.0f / 128) + EPS);
                    *(GAS u32x4*)(rp + 192 * bj) = pk8(acc[ai][bj][m][0] * rn * g0, acc[ai][bj][m][1] * rn * g1); }
                asm volatile("" ::: "memory"); }
        } else {
            const int i0 = 16 * (wc & 1) + 4 * fq;
            const f32x4 ga = *(const GAS f32x4*)(P.g_qp + l * 64 + i0), gb = *(const GAS f32x4*)(P.g_qp + l * 64 + 32 + i0);
            const float* rope = (const float*)(ws + WS_ROPE);
            f32x4 cs[2][4][2];
            FOR_AM { const int row = row0 + ai * 128 + m * 16; const int pos = row < MP ? (row & (SEQ - 1)) : PAST + ((row - MP) & (DSEQ - 1));
                cs[ai][m][0] = *(const GAS f32x4*)(rope + ((size_t)pos * 32 + i0) * 2); cs[ai][m][1] = *(const GAS f32x4*)(rope + ((size_t)pos * 32 + i0) * 2 + 4); }
            FOR_AM { const int rloc = ai * 128 + wr * 64 + m * 16 + fr; const int row = row0 + ai * 128 + m * 16;
                const f32x4 cs0 = cs[ai][m][0], cs1 = cs[ai][m][1];
#pragma unroll
                for (int bj = 0; bj < 2; ++bj) { const f32x4 t = xrd(Xr, rloc, bj); const float rn = rsqrtf(((wc & 2) ? (t[2] + t[3]) : (t[0] + t[1])) * (1.0f / 64) + EPS);
                    const f32x4 a = acc[ai][bj][m][0] * rn, b = acc[ai][bj][m][1] * rn;
                    const float x10 = a[0] * ga[0], x20 = a[1] * gb[0], x11 = a[2] * ga[1], x21 = a[3] * gb[1], x12 = b[0] * ga[2], x22 = b[1] * gb[2], x13 = b[2] * ga[3], x23 = b[3] * gb[3];
                    const float o10 = x10 * cs0[0] - x20 * cs0[1], o20 = x20 * cs0[0] + x10 * cs0[1], o11 = x11 * cs0[2] - x21 * cs0[3], o21 = x21 * cs0[2] + x11 * cs0[3];
                    const float o12 = x12 * cs1[0] - x22 * cs1[1], o22 = x22 * cs1[0] + x12 * cs1[1], o13 = x13 * cs1[2] - x23 * cs1[3], o23 = x23 * cs1[2] + x13 * cs1[3];
                    const int head = 4 * (pn - 8) + 2 * bj + (wc >> 1);
                    bf16* rp = QN + (size_t)row * 3072 + 192 * head + 128 + i0;
                    u32x2 w1 = {cvtpk(o10, o11), cvtpk(o12, o13)}, w2 = {cvtpk(o20, o21), cvtpk(o22, o23)};
                    *(GAS u32x2*)rp = w1; *(GAS u32x2*)(rp + 32) = w2; }
                asm volatile("" ::: "memory"); }
        }
    }
};

struct Epi2k {
    static constexpr bool SYNC = true;
    const Params& P; int l; LAS float* X;
    __device__ __forceinline__ void operator()(Acc& acc, const Unit& u, int wr, int wc, int fr, int fq, int ui) const {
        unsigned char* ws = opaque_ptr(P.ws);
        const int row0 = u.pm * BM + wr * 64 + fr, cl = wc * 32 + 8 * fq;
        row_scale(acc, (const float*)(ws + WS_CTL) + CW_SSQCKV + l * MA, 1.0f / KVL, row0);
        { float ss[2][4][2]; part_ss(acc, ss); xchg_ss(ss, X + (ui & 1) * 2048, wr, wc, fr, fq); }
        const LAS float* Xr = X + (ui & 1) * 2048;
        const f32x4 g0 = *(const GAS f32x4*)(P.g_kn + l * 128 + cl), g1 = *(const GAS f32x4*)(P.g_kn + l * 128 + cl + 4);
        FOR_AM { const int rloc = ai * 128 + wr * 64 + m * 16 + fr; const int row = row0 + ai * 128 + m * 16; size_t drow;
            if (u.pm < MP / BM) drow = (size_t)(WS_KVP / 2) + (size_t)row * 4096;
            else { const int r = row - MP; drow = (size_t)(WS_KVS / 2) + (size_t)((r >> 4) * SKV + PAST + (r & 15)) * 4096; }
            bf16* rp = (bf16*)ws + drow + u.pn * 256 + cl;
            const f32x4 t = xrd(Xr, rloc, 0); const float rn = rsqrtf(((t[0] + t[1]) + (t[2] + t[3])) * (1.0f / 128) + EPS);
            *(GAS u32x4*)rp = pk8(acc[ai][0][m][0] * rn * g0, acc[ai][0][m][1] * rn * g1); *(GAS u32x4*)(rp + 128) = pk8(acc[ai][1][m][0], acc[ai][1][m][1]);
            asm volatile("" ::: "memory"); }
    }
};
struct Epi2c {
    static constexpr bool SYNC = false;
    const Params& P; int l;
    __device__ __forceinline__ void operator()(Acc& acc, const Unit& u, int wr, int wc, int fr, int fq, int ui) const {
        unsigned char* ws = opaque_ptr(P.ws);
        const int row0 = u.pm * BM + wr * 64 + fr, cl = wc * 32 + 8 * fq;
        FOR_AM { const int c = row0 + ai * 128 + m * 16;
            bf16* rp = (bf16*)(ws + WS_KVS) + (size_t)((c >> 11) * SKV + (c & (PAST - 1))) * 4096 + u.pn * 256 + cl;
            __builtin_nontemporal_store(pk8(acc[ai][0][m][0], acc[ai][0][m][1]), (GAS u32x4*)rp); __builtin_nontemporal_store(pk8(acc[ai][1][m][0], acc[ai][1][m][1]), (GAS u32x4*)(rp + 128));
            asm volatile("" ::: "memory"); }
    }
};

struct Epi3 {
    static constexpr bool SYNC = false;
    const Params& P; int l; bool dry;
    __device__ __forceinline__ void operator()(Acc& acc, const Unit& u, int wr, int wc, int fr, int fq, int ui) const {
        unsigned char* ws = opaque_ptr(P.ws);
        const float* resid = l == 0 ? P.x_p : (const float*)(ws + WS_Y0); float* outp = l == 0 ? (float*)(ws + WS_Y0) : P.out + O_YP;
        bf16* hnext = (bf16*)(ws + WS_H); const float* gnext = P.g_norm + DM; float* ssqn = (float*)(ws + WS_CTL) + CW_SSQH + MA;
        const int row0 = u.pm * BM + wr * 64 + fr, col0 = u.pn * BM + wc * 32 + 8 * fq;
        f32x4 gn[2][2];
#pragma unroll
        for (int bj = 0; bj < 2; ++bj) { gn[bj][0] = *(const GAS f32x4*)(gnext + col0 + bj * 128); gn[bj][1] = *(const GAS f32x4*)(gnext + col0 + bj * 128 + 4); }
#pragma unroll
        for (int ai = 0; ai < 2; ++ai) {
            f32x4 rv[4][2][2];
#pragma unroll
            for (int m = 0; m < 4; ++m) { const size_t off = (size_t)(row0 + ai * 128 + m * 16) * DM + col0;
#pragma unroll
                for (int bj = 0; bj < 2; ++bj) { rv[m][bj][0] = *(const GAS f32x4*)(resid + off + bj * 128); rv[m][bj][1] = *(const GAS f32x4*)(resid + off + bj * 128 + 4); } }
#pragma unroll
            for (int m = 0; m < 4; ++m) { const size_t off = (size_t)(row0 + ai * 128 + m * 16) * DM + col0; float s = 0.f;
#pragma unroll
                for (int bj = 0; bj < 2; ++bj) {
                    const f32x4 y0 = rv[m][bj][0] + acc[ai][bj][m][0], y1 = rv[m][bj][1] + acc[ai][bj][m][1];
                    if (l == 1) { __builtin_nontemporal_store(y0, (GAS f32x4*)(outp + off + bj * 128)); __builtin_nontemporal_store(y1, (GAS f32x4*)(outp + off + bj * 128 + 4)); }
                    else { *(GAS f32x4*)(outp + off + bj * 128) = y0; *(GAS f32x4*)(outp + off + bj * 128 + 4) = y1; }
                    if (l == 0) { s += (y0[0] * y0[0] + y0[1] * y0[1]) + (y0[2] * y0[2] + y0[3] * y0[3]) + (y1[0] * y1[0] + y1[1] * y1[1]) + (y1[2] * y1[2] + y1[3] * y1[3]);
                        *(GAS u32x4*)(hnext + (size_t)(row0 + ai * 128 + m * 16) * HP + col0 + bj * 128) = pk8(y0 * gn[bj][0], y1 * gn[bj][1]); } }
                if (l == 0) { s += xor16(s); s = sum32(s); if (fq == 0 && !dry) atomic_addf(ssqn + row0 + ai * 128 + m * 16, s); } }
            asm volatile("" ::: "memory"); }
    }
};
struct Epi3s {
    static constexpr bool SYNC = false;
    const Params& P; int l;
    __device__ __forceinline__ void operator()(Acc& acc, const Unit& u, int wr, int wc, int fr, int fq, int ui) const {
        float* slab = (float*)(opaque_ptr(P.ws) + WS_SLAB) + (size_t)(u.ko >> 8) * MS * DM;
        store_f32(acc, slab, DM, wr * 64 + fr, u.pn * BM + wc * 32 + 8 * fq);
    }
};
}
using pg8::Acc;

namespace att {
constexpr int K_OFF = 0;
constexpr int V_OFF = 73728;
constexpr int CB_OFF = 122880;
constexpr int SCR_OFF = CB_OFF + 10240;
constexpr int RED_OFF = SCR_OFF + 2048;
static_assert(RED_OFF + 64 <= MISC_OFF, "attention LDS");
__device__ __forceinline__ int crow(int r, int hi) { return (r & 3) + 8 * (r >> 2) + 4 * hi; }
__device__ __forceinline__ int offb(int row, int ch) { return 256 * row + 16 * (ch ^ (((row & 3) << 2) | ((row >> 2) & 3))); }
#define TRRD(dst, addr, off) asm volatile("ds_read_b64_tr_b16 %0, %1 offset:%2" : "=&v"(dst) : "v"(addr), "i"(off) : "memory")

template <int NPT>
__device__ __forceinline__ void block_scan_store(float (&v)[NPT], LAS float* cb, LAS float* red, int tid) {
    const int lane = tid & 63, wid = tid >> 6;
#pragma unroll
    for (int e = 1; e < NPT; ++e) v[e] += v[e - 1];
    float tot = v[NPT - 1], inc = tot;
#pragma unroll
    for (int d = 1; d < 64; d <<= 1) { const float t = __int_as_float(__builtin_amdgcn_ds_bpermute((lane - d) << 2, __float_as_int(inc))); if (lane >= d) inc += t; }
    if (lane == 63) red[wid] = inc;
    __syncthreads();
    float off = inc - tot;
#pragma unroll
    for (int w = 0; w < 8; ++w) if (w < wid) off += red[w];
#pragma unroll
    for (int e = 0; e < NPT; ++e) cb[NPT * tid + e] = (off + v[e]) * LOG2E;
    __syncthreads();
}

template <int DQK, bool FOX>
__device__ __forceinline__ void attn_big_unit(LAS char* lds, const bf16* Q, int qp, const bf16* K0, int k0p, const bf16* K1, int k1p, const bf16* V, int vp, const bf16* G, bf16* O, int qb) {
    constexpr int RB = DQK * 2, KBUF = 64 * RB, ND = DQK / 16, NIK = KBUF / 8192;
    constexpr float C2 = FOX ? FOX_C2 : MLA_C2;
    const int tid = opaque_tid(), wid = __builtin_amdgcn_readfirstlane(tid >> 6), lane = tid & 63, r32 = lane & 31, hi = lane >> 5;
    LAS char* Kl = lds + K_OFF; LAS char* Vl = lds + V_OFF; const LAS float* cb = (const LAS float*)(lds + CB_OFF); LAS float* scr = (LAS float*)(lds + SCR_OFF) + wid * 64;
    const int NT = 4 * (qb + 1), qlo = 256 * qb + 32 * wid;
    bf16x8 qr[ND];
#pragma unroll
    for (int d0 = 0; d0 < ND; ++d0) qr[d0] = *(const GAS bf16x8*)(Q + (size_t)(qlo + r32) * qp + d0 * 16 + hi * 8);
    const GAS char* kp[NIK]; unsigned kstep[NIK]; const GAS char* vpp[2];
#pragma unroll
    for (int j = 0; j < NIK; ++j) { const int o = (wid * NIK + j) * 1024 + lane * 16, row = o / RB, cpos = (o % RB) / 16, c = DQK == 128 ? (cpos ^ (row & 15)) : ((cpos & ~7) | ((cpos ^ (row >> 1)) & 7));
        if (DQK == 192 && c >= 16) { kp[j] = (const GAS char*)(K1 + (size_t)row * k1p + (c - 16) * 8); kstep[j] = 64u * (unsigned)k1p * 2u; }
        else { kp[j] = (const GAS char*)(K0 + (size_t)row * k0p + c * 8); kstep[j] = 64u * (unsigned)k0p * 2u; } }
#pragma unroll
    for (int j = 0; j < 2; ++j) { const int o = (wid * 2 + j) * 1024 + lane * 16, row = o >> 8, cpos = (o & 255) >> 4, ch = cpos ^ (((row & 3) << 2) | ((row >> 2) & 3));
        vpp[j] = (const GAS char*)(V + (size_t)row * vp + ch * 8); }
    const unsigned vstep = 64u * (unsigned)vp * 2u;
#define DMA_TILE(kb_, vb_) do { \
        _Pragma("unroll") for (int j = 0; j < NIK; ++j) { __builtin_amdgcn_global_load_lds((const GAS unsigned*)kp[j], (LAS unsigned*)(Kl + (kb_) + (wid * NIK + j) * 1024), 16, 0, 0); kp[j] += kstep[j]; } \
        _Pragma("unroll") for (int j = 0; j < 2; ++j) { __builtin_amdgcn_global_load_lds((const GAS unsigned*)vpp[j], (LAS unsigned*)(Vl + (vb_) + (wid * 2 + j) * 1024), 16, 0, 0); vpp[j] += vstep; } } while (0)
#define WAIT_ONE_AHEAD() do { if (NIK == 3) asm volatile("s_waitcnt vmcnt(5)" ::: "memory"); else asm volatile("s_waitcnt vmcnt(4)" ::: "memory"); } while (0)
#define BARRIER() do { asm volatile("s_waitcnt lgkmcnt(0)" ::: "memory"); __builtin_amdgcn_s_barrier(); asm volatile("" ::: "memory"); } while (0)
    float m_reg = -1e30f, l_reg = 0.f; f32x16 o[4];
#pragma unroll
    for (int c = 0; c < 4; ++c) o[c] = f32x16{};
    const int hq = (lane & 15) >> 2, hp = lane & 3, hblk = (lane >> 4) & 1;
    const unsigned va0 = (unsigned)(size_t)Vl + 256 * (8 * hi + hq) + 64 * hq + 16 * ((2 * hblk + (hp >> 1)) ^ (2 * hi)) + 8 * (hp & 1);
    const int kq = r32 * RB, kswz = DQK == 128 ? ((r32 & 15) << 4) : (((r32 >> 1) & 7) << 4);
    bf16x8 pa[4];
#define PVH(vt, c0) do { s16x4 l0, l1, l2, l3, h0, h1, h2, h3, m0, m1, m2, m3, n0, n1, n2, n3; \
        const unsigned aL = (vt) ^ (unsigned)((c0) << 6), aH = (vt) ^ (unsigned)(((c0) << 6) | (1 << 4) | (1 << 10)), bL = (vt) ^ (unsigned)(((c0) + 1) << 6), bH = (vt) ^ (unsigned)((((c0) + 1) << 6) | (1 << 4) | (1 << 10)); \
        TRRD(l0, aL, 0); TRRD(h0, aH, 0); TRRD(l1, aL, 4096); TRRD(h1, aH, 4096); TRRD(l2, aL, 8192); TRRD(h2, aH, 8192); TRRD(l3, aL, 12288); TRRD(h3, aH, 12288); \
        TRRD(m0, bL, 0); TRRD(n0, bH, 0); TRRD(m1, bL, 4096); TRRD(n1, bH, 4096); TRRD(m2, bL, 8192); TRRD(n2, bH, 8192); TRRD(m3, bL, 12288); TRRD(n3, bH, 12288); \
        asm volatile("s_waitcnt lgkmcnt(0)" ::: "memory"); SBAR(); \
        o[c0] = __builtin_amdgcn_mfma_f32_32x32x16_bf16((bf16x8){l0[0], l0[1], l0[2], l0[3], h0[0], h0[1], h0[2], h0[3]}, pa[0], o[c0], 0, 0, 0); \
        o[c0 + 1] = __builtin_amdgcn_mfma_f32_32x32x16_bf16((bf16x8){m0[0], m0[1], m0[2], m0[3], n0[0], n0[1], n0[2], n0[3]}, pa[0], o[c0 + 1], 0, 0, 0); \
        o[c0] = __builtin_amdgcn_mfma_f32_32x32x16_bf16((bf16x8){l1[0], l1[1], l1[2], l1[3], h1[0], h1[1], h1[2], h1[3]}, pa[1], o[c0], 0, 0, 0); \
        o[c0 + 1] = __builtin_amdgcn_mfma_f32_32x32x16_bf16((bf16x8){m1[0], m1[1], m1[2], m1[3], n1[0], n1[1], n1[2], n1[3]}, pa[1], o[c0 + 1], 0, 0, 0); \
        o[c0] = __builtin_amdgcn_mfma_f32_32x32x16_bf16((bf16x8){l2[0], l2[1], l2[2], l2[3], h2[0], h2[1], h2[2], h2[3]}, pa[2], o[c0], 0, 0, 0); \
        o[c0 + 1] = __builtin_amdgcn_mfma_f32_32x32x16_bf16((bf16x8){m2[0], m2[1], m2[2], m2[3], n2[0], n2[1], n2[2], n2[3]}, pa[2], o[c0 + 1], 0, 0, 0); \
        o[c0] = __builtin_amdgcn_mfma_f32_32x32x16_bf16((bf16x8){l3[0], l3[1], l3[2], l3[3], h3[0], h3[1], h3[2], h3[3]}, pa[3], o[c0], 0, 0, 0); \
        o[c0 + 1] = __builtin_amdgcn_mfma_f32_32x32x16_bf16((bf16x8){m3[0], m3[1], m3[2], m3[3], n3[0], n3[1], n3[2], n3[3]}, pa[3], o[c0 + 1], 0, 0, 0); } while (0)
#define PV(vb_) do { const unsigned vt_ = va0 + (unsigned)(vb_); PVH(vt_, 0); PVH(vt_, 2); } while (0)
    DMA_TILE(0, 0);
    if (NT > 1) { DMA_TILE(KBUF, 16384); WAIT_ONE_AHEAD(); } else asm volatile("s_waitcnt vmcnt(0)" ::: "memory");
    BARRIER();
    int bcur = 0, bnxt = 1, bnn = 2;
    for (int t = 0; t < NT; ++t) {
        if (t + 2 < NT) DMA_TILE(bnn * KBUF, bnn * 16384);
        const bool act = FOX ? (64 * t <= qlo + 31) : (t <= 4 * qb + (wid >> 1));
        if (act) {
            f32x16 p0 = f32x16{}, p1 = f32x16{};
            const LAS char* kb = Kl + bcur * KBUF + kq;
            constexpr int GS = DQK == 128 ? 4 : 3, NG = ND / GS;
            bf16x8 ka[2][GS], kc[2][GS];
#define KRD(gi, sl) do { _Pragma("unroll") for (int j = 0; j < GS; ++j) { const int cB = (((gi) * GS + j) * 32 + hi * 16) ^ kswz; ka[sl][j] = *(const LAS bf16x8*)(kb + cB); kc[sl][j] = *(const LAS bf16x8*)(kb + 32 * RB + cB); } } while (0)
#define KMM(gi, sl) do { _Pragma("unroll") for (int j = 0; j < GS; ++j) { p0 = __builtin_amdgcn_mfma_f32_32x32x16_bf16(ka[sl][j], qr[(gi) * GS + j], p0, 0, 0, 0); p1 = __builtin_amdgcn_mfma_f32_32x32x16_bf16(kc[sl][j], qr[(gi) * GS + j], p1, 0, 0, 0); } } while (0)
            KRD(0, 0); SBAR(); KRD(1, 1); SBAR(); KMM(0, 0); SBAR();
            if (NG == 4) { KRD(2, 0); SBAR(); KMM(1, 1); SBAR(); KRD(3, 1); SBAR(); KMM(2, 0); SBAR(); KMM(3, 1); SBAR(); }
            else { KMM(1, 1); SBAR(); }
#undef KRD
#undef KMM
            if (FOX) {
#pragma unroll
                for (int g = 0; g < 4; ++g) { const f32x4 b0 = *(const LAS f32x4*)(cb + 64 * t + 8 * g + 4 * hi), b1 = *(const LAS f32x4*)(cb + 64 * t + 32 + 8 * g + 4 * hi);
#pragma unroll
                    for (int e = 0; e < 4; ++e) { p0[4 * g + e] = fmaf(p0[4 * g + e], C2, -b0[e]); p1[4 * g + e] = fmaf(p1[4 * g + e], C2, -b1[e]); } }
                if (64 * t + 63 > qlo) { asm volatile("" ::: "memory");
                    const int dq = qlo + r32 - 64 * t - 4 * hi; const float NEG = -__builtin_inff();
#pragma unroll
                    for (int r = 0; r < 16; ++r) { const int c = (r & 3) + 8 * (r >> 2); if (c > dq) p0[r] = NEG; if (c + 32 > dq) p1[r] = NEG; } }
            } else {
#pragma unroll
                for (int r = 0; r < 16; ++r) { p0[r] *= C2; p1[r] *= C2; }
            }
            float pmax = p0[0];
#pragma unroll
            for (int r = 1; r < 16; ++r) pmax = fmaxf(pmax, p0[r]);
#pragma unroll
            for (int r = 0; r < 16; ++r) pmax = fmaxf(pmax, p1[r]);
            pmax = max32(pmax);
            float mn, alpha;
            if (__all(pmax - m_reg <= 8.0f)) { mn = m_reg; alpha = 1.f; }
            else { mn = fmaxf(m_reg, pmax); alpha = __builtin_amdgcn_exp2f(m_reg - mn); m_reg = mn; }
            float ps = 0.f;
#pragma unroll
            for (int r = 0; r < 16; ++r) { p0[r] = __builtin_amdgcn_exp2f(p0[r] - mn); p1[r] = __builtin_amdgcn_exp2f(p1[r] - mn); ps += p0[r] + p1[r]; }
            ps = sum32(ps);
            l_reg = l_reg * alpha + ps;
            if (__any(alpha < 1.f)) {
#pragma unroll
                for (int c = 0; c < 4; ++c) o[c] *= alpha; }
#define PK4(P, B_, OUT) do { unsigned a0_ = cvtpk(P[B_ + 0], P[B_ + 1]), a1_ = cvtpk(P[B_ + 2], P[B_ + 3]), b0_ = cvtpk(P[B_ + 4], P[B_ + 5]), b1_ = cvtpk(P[B_ + 6], P[B_ + 7]); \
        auto r0_ = __builtin_amdgcn_permlane32_swap(a0_, b0_, false, false); auto r1_ = __builtin_amdgcn_permlane32_swap(a1_, b1_, false, false); \
        u32x4 w_ = {r0_[0], r1_[0], r0_[1], r1_[1]}; OUT = __builtin_bit_cast(bf16x8, w_); } while (0)
            PK4(p0, 0, pa[0]); PK4(p0, 8, pa[1]); PK4(p1, 0, pa[2]); PK4(p1, 8, pa[3]);
#undef PK4
            PV(bcur * 16384);
        }
        if (t + 2 < NT) WAIT_ONE_AHEAD(); else asm volatile("s_waitcnt vmcnt(0)" ::: "memory");
        BARRIER();
        { const int tmp_ = bcur; bcur = bnxt; bnxt = bnn; bnn = tmp_; }
    }
#undef PV
#undef PVH
#undef DMA_TILE
#undef WAIT_ONE_AHEAD
#undef BARRIER
    { const float rl = __builtin_amdgcn_rcpf(l_reg); const size_t ro = (size_t)(qlo + r32) * DM + 4 * hi, oo = (size_t)(qlo + r32) * OP + 8 * hi;
      u32x2 gt[4][4];
#pragma unroll
      for (int c = 0; c < 4; ++c)
#pragma unroll
          for (int g = 0; g < 4; ++g) gt[c][g] = *(const GAS u32x2*)(G + ro + 32 * c + 8 * g);
#pragma unroll
      for (int c = 0; c < 4; ++c)
#pragma unroll
          for (int gp = 0; gp < 2; ++gp) { unsigned w[2][2];
#pragma unroll
              for (int k = 0; k < 2; ++k) { const int g = 2 * gp + k; const u32x2 gg = gt[c][g];
                  const float g0 = __uint_as_float(gg[0] << 16), g1 = __uint_as_float(gg[0] & 0xffff0000u), g2 = __uint_as_float(gg[1] << 16), g3 = __uint_as_float(gg[1] & 0xffff0000u);
                  w[k][0] = cvtpk(o[c][4 * g + 0] * rl * g0, o[c][4 * g + 1] * rl * g1); w[k][1] = cvtpk(o[c][4 * g + 2] * rl * g2, o[c][4 * g + 3] * rl * g3); }
              auto r0 = __builtin_amdgcn_permlane32_swap(w[0][0], w[1][0], false, false); auto r1 = __builtin_amdgcn_permlane32_swap(w[0][1], w[1][1], false, false);
              u32x4 st = {r0[0], r1[0], r0[1], r1[1]};
              *(GAS u32x4*)(O + oo + 32 * c + 16 * gp) = st; } }
    asm volatile("s_waitcnt vmcnt(0) lgkmcnt(0)" ::: "memory");
    __builtin_amdgcn_s_barrier();
}

template <int DQK, bool FOX>
__device__ __forceinline__ void attn_small_unit(LAS char* lds, const bf16* Q, int qp, const float* cK, const float* cV, const bf16* nK, const bf16* nV,
                                                const bf16* K0, const bf16* K1, const bf16* V, const bf16* G, bf16* O, const float* gkn = nullptr) {
    constexpr int RB = DQK * 2, NS = DQK / 32;
    constexpr float C2 = FOX ? FOX_C2 : MLA_C2;
    const int tid = opaque_tid(), wid = __builtin_amdgcn_readfirstlane(tid >> 6), lane = tid & 63, fr = lane & 15, fq = lane >> 4;
    LAS char* Kl = lds + K_OFF; LAS char* Vl = lds + V_OFF; const LAS float* cb = (const LAS float*)(lds + CB_OFF);
    bf16x8 qf[NS];
#pragma unroll
    for (int s = 0; s < NS; ++s) qf[s] = *(const GAS bf16x8*)(Q + (size_t)fr * qp + 32 * s + 8 * fq);
    const int srow = tid >> 2, sq = tid & 3;
    const int kswr = (srow & 7) << 4;
    float m_reg = -1e30f, l_reg = 0.f; f32x4 o[8];
#pragma unroll
    for (int c = 0; c < 8; ++c) o[c] = (f32x4){0.f, 0.f, 0.f, 0.f};
    const int krow = 16 * wid + fr, kswz = (krow & 7) << 4;
    const int hq = (lane & 15) >> 2, hp = lane & 3, vrow = 16 * wid + 4 * fq + hq;
    const unsigned va0 = (unsigned)(size_t)Vl + 256 * vrow + 16 * ((hp >> 1) ^ (4 * hq + fq)) + 8 * (hp & 1);
    auto process = [&](int t) {
        f32x4 s = {0.f, 0.f, 0.f, 0.f};
        const LAS char* kb = Kl + krow * RB;
#pragma unroll
        for (int st = 0; st < NS; ++st) { const bf16x8 kf = *(const LAS bf16x8*)(kb + ((64 * st + 16 * fq) ^ kswz)); s = __builtin_amdgcn_mfma_f32_16x16x32_bf16(kf, qf[st], s, 0, 0, 0); }
        const int key0 = 128 * t + 16 * wid + 4 * fq;
        if (FOX) { const f32x4 bb = *(const LAS f32x4*)(cb + key0);
#pragma unroll
            for (int e = 0; e < 4; ++e) s[e] = fmaf(s[e], C2, -bb[e]); }
        else { s *= C2; }
        const float NEG = -__builtin_inff();
#pragma unroll
        for (int e = 0; e < 4; ++e) { const int key = key0 + e; if (key >= SKV || (FOX && key > PAST + fr)) s[e] = NEG; }
        float pmax = fmaxf(fmaxf(s[0], s[1]), fmaxf(s[2], s[3]));
        pmax = fmaxf(pmax, xor16(pmax)); pmax = max32(pmax);
        const float mn = fmaxf(m_reg, pmax), alpha = __builtin_amdgcn_exp2f(m_reg - mn); m_reg = mn;
        float p[4], ps = 0.f;
#pragma unroll
        for (int e = 0; e < 4; ++e) { p[e] = __builtin_amdgcn_exp2f(s[e] - mn); ps += p[e]; }
        ps += xor16(ps); ps = sum32(ps);
        l_reg = l_reg * alpha + ps;
        u32x4 pw = {cvtpk(p[0], p[1]), cvtpk(p[2], p[3]), 0u, 0u}; const bf16x8 pf = __builtin_bit_cast(bf16x8, pw);
        s16x4 v0, v1, v2, v3, v4, v5, v6, v7;
        TRRD(v0, va0, 0); TRRD(v1, va0 ^ 32u, 0); TRRD(v2, va0 ^ 64u, 0); TRRD(v3, va0 ^ 96u, 0); TRRD(v4, va0 ^ 128u, 0); TRRD(v5, va0 ^ 160u, 0); TRRD(v6, va0 ^ 192u, 0); TRRD(v7, va0 ^ 224u, 0);
        asm volatile("s_waitcnt lgkmcnt(0)" ::: "memory"); SBAR();
#define PVS(c, vv) o[c] = __builtin_amdgcn_mfma_f32_16x16x32_bf16((bf16x8){vv[0], vv[1], vv[2], vv[3], 0, 0, 0, 0}, pf, o[c] * alpha, 0, 0, 0)
        PVS(0, v0); PVS(1, v1); PVS(2, v2); PVS(3, v3); PVS(4, v4); PVS(5, v5); PVS(6, v6); PVS(7, v7);
#undef PVS
    };
    if constexpr (FOX) {
        f32x4 fk[8], fv[8];
        const int pc = tid & 31, rb = tid >> 5;
        const float* kp = cK + (size_t)rb * 2048 + pc * 4; const float* vp_ = cV + (size_t)rb * 2048 + pc * 4;
        const int kwf = rb * RB + (((pc >> 1) * 16) ^ ((rb & 7) << 4)) + (pc & 1) * 8, vwf = offb(rb, pc >> 1) + (pc & 1) * 8;
#define LOADF(t) do { _Pragma("unroll") for (int i = 0; i < 8; ++i) { fk[i] = __builtin_nontemporal_load((const GAS f32x4*)(kp + ((size_t)(t) * 128 + 16 * i) * 2048)); fv[i] = __builtin_nontemporal_load((const GAS f32x4*)(vp_ + ((size_t)(t) * 128 + 16 * i) * 2048)); } } while (0)
#define WRITEF() do { _Pragma("unroll") for (int i = 0; i < 8; ++i) { u32x2 kw_ = {cvtpk(fk[i][0], fk[i][1]), cvtpk(fk[i][2], fk[i][3])}, vw_ = {cvtpk(fv[i][0], fv[i][1]), cvtpk(fv[i][2], fv[i][3])}; \
            *(LAS u32x2*)(Kl + kwf + 16 * i * RB) = kw_; *(LAS u32x2*)(Vl + vwf + 16 * i * 256) = vw_; } } while (0)
        LOADF(0);
        for (int t = 0; t < 16; ++t) {
            WRITEF();
            __syncthreads();
            if (t + 1 < 16) LOADF(t + 1);
            process(t);
            __syncthreads();
        }
#undef LOADF
#undef WRITEF
#pragma unroll
        for (int i = 0; i < 4; ++i) { bf16x8 a = {}, b = {};
            if (srow < 16) { a = *(const GAS bf16x8*)(nK + (size_t)srow * FW + sq * 32 + 8 * i); b = *(const GAS bf16x8*)(nV + (size_t)srow * FW + sq * 32 + 8 * i); }
            *(LAS bf16x8*)(Kl + srow * RB + (((sq * 4 + i) * 16) ^ kswr)) = a; *(LAS bf16x8*)(Vl + offb(srow, sq * 4 + i)) = b; }
        __syncthreads();
        process(16);
        __syncthreads();
    } else {
        bf16x8 bk[4], bk1[2], bv[4];
        const int c16 = tid & 15, rb16 = tid >> 4, c8 = tid & 7, rb8 = tid >> 3;
        const int kwb = rb16 * RB + ((c16 * 16) ^ ((rb16 & 7) << 4)), vwb = offb(rb16, c16), k1wb = rb8 * RB + 256 + ((c8 * 16) ^ ((rb8 & 7) << 4));
#define LOADB(t) do { \
            _Pragma("unroll") for (int i = 0; i < 4; ++i) { int rowc_ = 128 * (t) + rb16 + 32 * i; rowc_ = rowc_ < SKV ? rowc_ : SKV - 1; \
                bk[i] = __builtin_nontemporal_load((const GAS bf16x8*)(K0 + (size_t)rowc_ * 4096 + c16 * 8)); bv[i] = __builtin_nontemporal_load((const GAS bf16x8*)(V + (size_t)rowc_ * 4096 + c16 * 8)); } \
            _Pragma("unroll") for (int i = 0; i < 2; ++i) { int rowc_ = 128 * (t) + rb8 + 64 * i; rowc_ = rowc_ < SKV ? rowc_ : SKV - 1; bk1[i] = *(const GAS bf16x8*)(K1 + (size_t)rowc_ * 64 + c8 * 8); } } while (0)
        const f32x4 gk0 = *(const GAS f32x4*)(gkn + c16 * 8), gk1 = *(const GAS f32x4*)(gkn + c16 * 8 + 4);
        LOADB(0);
        for (int t = 0; t < 17; ++t) {
            if (t < 16) {
#pragma unroll
                for (int i = 0; i < 4; ++i) { const u32x4 w = __builtin_bit_cast(u32x4, bk[i]); float f[8];
#pragma unroll
                    for (int e = 0; e < 4; ++e) { f[2 * e] = __uint_as_float(w[e] << 16); f[2 * e + 1] = __uint_as_float(w[e] & 0xffff0000u); }
                    float ss = (f[0] * f[0] + f[1] * f[1]) + (f[2] * f[2] + f[3] * f[3]) + (f[4] * f[4] + f[5] * f[5]) + (f[6] * f[6] + f[7] * f[7]);
                    ss += swz_xor(ss, SWZ_X1); ss += swz_xor(ss, SWZ_X2); ss += swz_xor(ss, SWZ_X4); ss += swz_xor(ss, SWZ_X8);
                    const float rn = rsqrtf(ss * (1.0f / 128) + EPS);
                    u32x4 o_ = {cvtpk(f[0] * rn * gk0[0], f[1] * rn * gk0[1]), cvtpk(f[2] * rn * gk0[2], f[3] * rn * gk0[3]), cvtpk(f[4] * rn * gk1[0], f[5] * rn * gk1[1]), cvtpk(f[6] * rn * gk1[2], f[7] * rn * gk1[3])};
                    bk[i] = __builtin_bit_cast(bf16x8, o_); } }
#pragma unroll
            for (int i = 0; i < 4; ++i) { *(LAS bf16x8*)(Kl + kwb + 32 * i * RB) = bk[i]; *(LAS bf16x8*)(Vl + vwb + 32 * i * 256) = bv[i]; }
#pragma unroll
            for (int i = 0; i < 2; ++i) *(LAS bf16x8*)(Kl + k1wb + 64 * i * RB) = bk1[i];
            __syncthreads();
            if (t + 1 < 17) LOADB(t + 1);
            process(t);
            __syncthreads();
        }
#undef LOADB
    }
    LAS float* Ow = (LAS float*)(lds + K_OFF); LAS float* ml = (LAS float*)(lds + K_OFF + 65536);
#pragma unroll
    for (int c = 0; c < 8; ++c) *(LAS f32x4*)(Ow + (wid * 16 + fr) * 128 + 16 * c + 4 * fq) = o[c];
    if (fq == 0) { ml[wid * 32 + fr] = m_reg; ml[wid * 32 + 16 + fr] = l_reg; }
    __syncthreads();
    { const int q = tid >> 5, dg = tid & 31; float M = -1e30f;
#pragma unroll
      for (int w = 0; w < 8; ++w) M = fmaxf(M, ml[w * 32 + q]);
      float L = 0.f; f32x4 a = {0.f, 0.f, 0.f, 0.f};
#pragma unroll
      for (int w = 0; w < 8; ++w) { const float wt = __builtin_amdgcn_exp2f(ml[w * 32 + q] - M); L += wt * ml[w * 32 + 16 + q]; a += wt * *(const LAS f32x4*)(Ow + (w * 16 + q) * 128 + 4 * dg); }
      const float rl = 1.0f / L; const size_t ro = (size_t)q * DM + 4 * dg;
      const u32x2 gv = *(const GAS u32x2*)(G + ro);
      const float g0 = __uint_as_float(gv[0] << 16), g1 = __uint_as_float(gv[0] & 0xffff0000u), g2 = __uint_as_float(gv[1] << 16), g3 = __uint_as_float(gv[1] & 0xffff0000u);
      u32x2 w = {cvtpk(a[0] * rl * g0, a[1] * rl * g1), cvtpk(a[2] * rl * g2, a[3] * rl * g3)}; *(GAS u32x2*)(O + (size_t)q * OP + 4 * dg) = w; }
    __syncthreads();
}
}

struct Frame { LAS unsigned char* lds; int tid, lane, wave, vcu, G; };

enum { WK_IN = 0, WK_80 = 1, WK_QB = 2, WK_KVB = 3, WK_OUT = 4 };
__device__ __forceinline__ int srccol(int kind, int n) {
    if (kind == WK_IN) return n < 6144 ? n : (n < 8192 ? n + 16 : (n < 10240 ? n + 1616 : n - 2032));
    if (kind == WK_80) return n < 16 ? 6144 + n : (n < 80 ? 9728 + n : -1);
    if (kind == WK_QB) { if (n < 2048) return (n >> 7) * 192 + (n & 127); const int m = n - 2048; return (m >> 6) * 192 + 128 + ((m & 63) >> 1) + 32 * (m & 1); }
    return n;
}
__device__ __forceinline__ void transpose_item(const float* W, int Nsrc, int kind, bf16* WT, int wtp, int nblk, int ncol0, LAS float* scr, int item, int lane) {
    const int kb = item / nblk, nb = item % nblk, k0 = 64 * kb, n0 = ncol0 + 32 * nb;
    const int sc = srccol(kind, n0 + (lane & 31));
#pragma unroll 8
    for (int i = 0; i < 32; ++i) { const int kk = 2 * i + (lane >> 5); scr[kk * 33 + (lane & 31)] = sc >= 0 ? ((const GAS float*)W)[(size_t)(k0 + kk) * Nsrc + sc] : 0.f; }
    LDS_WAIT(); asm volatile("" ::: "memory");
    const int c = lane & 7;
#pragma unroll
    for (int j = 0; j < 4; ++j) { const int n = (lane >> 3) + 8 * j; const LAS float* s = scr + (8 * c) * 33 + n;
        u32x4 o; o.x = cvtpk(s[0 * 33], s[1 * 33]); o.y = cvtpk(s[2 * 33], s[3 * 33]); o.z = cvtpk(s[4 * 33], s[5 * 33]); o.w = cvtpk(s[6 * 33], s[7 * 33]);
        *(GAS u32x4*)(WT + (size_t)(n0 + n) * wtp + k0 + 8 * c) = o; }
    LDS_WAIT(); asm volatile("" ::: "memory");
}
__device__ __forceinline__ void transpose_item64(const float* W, int Nsrc, int kind, bf16* WT, int wtp, int nblk, LAS unsigned char* T, int item, int lane) {
    const int kb = item / nblk, nb = item % nblk, k0 = 64 * kb, n0 = 64 * nb;
    const int g = lane >> 4, c = lane & 15;
    const float* src = W + (size_t)(k0 + 16 * g) * Nsrc + srccol(kind, n0 + 4 * c);
    f32x4 v[16];
#pragma unroll
    for (int i = 0; i < 16; ++i) v[i] = __builtin_nontemporal_load((const GAS f32x4*)(src + (size_t)i * Nsrc));
#pragma unroll
    for (int j = 0; j < 4; ++j) { const int row = 4 * c + j;
        u32x4 lo = {cvtpk(v[0][j], v[1][j]), cvtpk(v[2][j], v[3][j]), cvtpk(v[4][j], v[5][j]), cvtpk(v[6][j], v[7][j])};
        u32x4 hi = {cvtpk(v[8][j], v[9][j]), cvtpk(v[10][j], v[11][j]), cvtpk(v[12][j], v[13][j]), cvtpk(v[14][j], v[15][j])};
        *(LAS u32x4*)(T + row * 128 + (((2 * g) ^ (c & 7)) * 16)) = lo; *(LAS u32x4*)(T + row * 128 + (((2 * g + 1) ^ (c & 7)) * 16)) = hi; }
    LDS_WAIT(); asm volatile("" ::: "memory");
#pragma unroll
    for (int i = 0; i < 8; ++i) { const int row = 8 * i + (lane >> 3), ch = lane & 7;
        const u32x4 o = *(const LAS u32x4*)(T + row * 128 + ((ch ^ ((row >> 2) & 7)) * 16));
        *(GAS u32x4*)(WT + (size_t)(n0 + row) * wtp + k0 + 8 * ch) = o; }
    LDS_WAIT(); asm volatile("" ::: "memory");
}
__device__ __forceinline__ float row_to_h(const float* xrow, const float* g, bf16* hrow, int lane) {
    float ss = 0.f; f32x4 v[16], gg[16];
#pragma unroll
    for (int j = 0; j < 16; ++j) v[j] = __builtin_nontemporal_load((const GAS f32x4*)(xrow + 4 * lane + 256 * j));
#pragma unroll
    for (int j = 0; j < 16; ++j) gg[j] = *(const GAS f32x4*)(g + 4 * lane + 256 * j);
#pragma unroll
    for (int j = 0; j < 16; ++j) {
        ss += (v[j][0] * v[j][0] + v[j][1] * v[j][1]) + (v[j][2] * v[j][2] + v[j][3] * v[j][3]); const f32x4 h = v[j] * gg[j];
        u32x2 w = {cvtpk(h[0], h[1]), cvtpk(h[2], h[3])}; *(GAS u32x2*)(hrow + 4 * lane + 256 * j) = w; }
    return wave_sum(ss);
}
#ifndef PH_ATTR
#define PH_ATTR __forceinline__
#endif
#define PHASE_FRAME(F0) Frame F = F0; F.tid = opaque_tid(); F.lane = F.tid & 63; asm volatile("" : "+s"(F.vcu), "+s"(F.G), "+s"(F.wave))
template <int PART>
__device__ __forceinline__ void convert_work(const Frame& F0, const Params& P) {
    PHASE_FRAME(F0);
    unsigned char* ws = opaque_ptr(P.ws);
    LAS unsigned char* T = F.lds + F.wave * 16384; LAS float* scr = (LAS float*)T;
    const int gw = F.vcu * 8 + F.wave, NGW = F.G * 8;
    constexpr int I_IN = 64 * (N1 / 64), I_OUT = 64 * 64, I_KVB = 8 * 64, I_QBN = 16 * 32, I_QBR = 16 * 32, I_80 = 64 * 3;
    if constexpr (PART == 0) {
        for (int it = gw; it < I_IN + I_80; it += NGW) {
            if (it < I_IN) transpose_item64(P.w_in, NIN, WK_IN, (bf16*)(ws + WS_WIN), WP, N1 / 64, T, it, F.lane);
            else transpose_item(P.w_in, NIN, WK_80, (bf16*)(ws + WS_W80), DM, 3, 0, scr, it - I_IN, F.lane);
        }
        { bf16* H = (bf16*)(ws + WS_H); float* ssq = (float*)(ws + WS_CTL) + CW_SSQH;
          for (int m = gw; m < MA; m += NGW) { const float* xr = m < MP ? P.x_p + (size_t)m * DM : P.x_s + (size_t)(m - MP) * DM;
              const float s = row_to_h(xr, P.g_norm, H + (size_t)m * HP, F.lane); if (F.lane == 0) ((GAS float*)ssq)[m] = s; } }
        const size_t gt = (size_t)F.vcu * 512 + F.tid, NGT = (size_t)F.G * 512;
        for (size_t i = gt; i < (size_t)SKV * 32; i += NGT) { const int pos = (int)(i >> 5), k = (int)(i & 31); const float inv = 1.0f / powf(10000.0f, (float)k / 32.0f); const float ang = (float)pos * inv;
            float sn, cs; sincosf(ang, &sn, &cs); GAS float* t = (GAS float*)(ws + WS_ROPE) + i * 2; t[0] = cs; t[1] = sn; }
    } else {
        constexpr int N1_ = I_IN, N2_ = N1_ + 2 * I_OUT, N3_ = N2_ + 2 * I_KVB, N4_ = N3_ + 2 * I_QBN, N5_ = N4_ + 2 * I_QBR, N6_ = N5_ + I_80;
        for (int it = gw; it < N6_; it += NGW) {
            if (it < N1_) { transpose_item64(P.w_in + (size_t)DM * NIN, NIN, WK_IN, (bf16*)(ws + WS_WIN + AL(SZ_WIN)), WP, N1 / 64, T, it, F.lane); continue; }
            if (it < N2_) { const int r = it - N1_, l = r / I_OUT; transpose_item64(P.w_out + (size_t)l * DM * DM, DM, WK_OUT, (bf16*)(ws + WS_WOUT + l * AL(SZ_WOUT)), WP, 64, T, r % I_OUT, F.lane); continue; }
            if (it < N3_) { const int r = it - N2_, l = r / I_KVB; transpose_item64(P.w_kvb + (size_t)l * KVL * 4096, 4096, WK_KVB, (bf16*)(ws + WS_WKVB + l * AL(SZ_WKVB)), KVL, 64, T, r % I_KVB, F.lane); continue; }
            if (it < N4_) { const int r = it - N3_, l = r / I_QBN; transpose_item64(P.w_qb + (size_t)l * QL * 3072, 3072, WK_QB, (bf16*)(ws + WS_WQB + l * AL(SZ_WQB)), QL, 32, T, r % I_QBN, F.lane); continue; }
            if (it < N5_) { const int r = it - N4_, l = r / I_QBR; transpose_item(P.w_qb + (size_t)l * QL * 3072, 3072, WK_QB, (bf16*)(ws + WS_WQB + l * AL(SZ_WQB)), QL, 32, 2048, scr, r % I_QBR, F.lane); continue; }
            transpose_item(P.w_in + (size_t)DM * NIN, NIN, WK_80, (bf16*)(ws + WS_W80 + AL(SZ_W80)), DM, 3, 0, scr, it - N5_, F.lane);
        }
        const size_t gt = (size_t)F.vcu * 512 + F.tid, NGT = (size_t)F.G * 512;
        { constexpr size_t per = (size_t)DBATCH * PAST * KVL / 8;
          for (size_t i0 = gt; i0 < 2 * per; i0 += 4 * NGT) { f32x4 a[4], b[4];
#pragma unroll
              for (int u = 0; u < 4; ++u) { const size_t i = i0 + u * NGT; if (i < 2 * per) { a[u] = __builtin_nontemporal_load((const GAS f32x4*)(P.c_ckv + i * 8)); b[u] = __builtin_nontemporal_load((const GAS f32x4*)(P.c_ckv + i * 8 + 4)); } }
#pragma unroll
              for (int u = 0; u < 4; ++u) { const size_t i = i0 + u * NGT; if (i < 2 * per) { const int l = (int)(i / per); const size_t j = i % per;
                  *(GAS bf16x8*)((bf16*)(ws + WS_CKVA + l * AL(SZ_CKVA)) + (size_t)MA * KVL + j * 8) = pack8(a[u], b[u]); } } } }
        for (size_t i = gt; i < (size_t)2 * DBATCH * PAST * 8; i += NGT) { const size_t per = (size_t)DBATCH * PAST * 8; const int l = (int)(i / per); const size_t j = i % per; const int row = (int)(j >> 3), c8 = (int)(j & 7);
            const float* s = P.c_kpe + ((size_t)l * per + j) * 8; bf16* d = (bf16*)(ws + WS_KPES + l * AL(SZ_KPES)) + (size_t)((row >> 11) * SKV + (row & (PAST - 1))) * 64 + c8 * 8;
            *(GAS bf16x8*)d = pack8(*(const GAS f32x4*)s, *(const GAS f32x4*)(s + 4)); }
    }
}

__device__ __forceinline__ void skinny_item(const Frame& F0, const Params& P, int l, int item) {
    PHASE_FRAME(F0);
    unsigned char* ws = opaque_ptr(P.ws);
    const bf16* H = (const bf16*)(ws + WS_H); const bf16* W = (const bf16*)(ws + WS_W80 + l * AL(SZ_W80));
    const int lane = F.lane, w = F.wave, r0 = 96 * item;
    const int fr = lane & 15, fq = lane >> 4;
    f32x4 acc[6][6];
#pragma unroll
    for (int tb = 0; tb < 6; ++tb)
#pragma unroll
        for (int cbk = 0; cbk < 6; ++cbk) acc[tb][cbk] = (f32x4){0.f, 0.f, 0.f, 0.f};
    const bf16* hp = H + (size_t)(r0 + fr) * HP + 512 * w + 8 * fq; const bf16* wp = W + (size_t)fr * DM + 512 * w + 8 * fq;
#pragma unroll 2
    for (int st = 0; st < 16; ++st) { bf16x8 hb[6], wa[6];
#pragma unroll
        for (int tb = 0; tb < 6; ++tb) hb[tb] = *(const GAS bf16x8*)(hp + (size_t)tb * 16 * HP + 32 * st);
#pragma unroll
        for (int cbk = 0; cbk < 6; ++cbk) wa[cbk] = *(const GAS bf16x8*)(wp + (size_t)cbk * 16 * DM + 32 * st);
#pragma unroll
        for (int tb = 0; tb < 6; ++tb)
#pragma unroll
            for (int cbk = 0; cbk < 6; ++cbk) acc[tb][cbk] = __builtin_amdgcn_mfma_f32_16x16x32_bf16(wa[cbk], hb[tb], acc[tb][cbk], 0, 0, 0); }
    LAS float* part = (LAS float*)F.lds;
#pragma unroll
    for (int p = 0; p < 3; ++p) {
#pragma unroll
        for (int tbl = 0; tbl < 2; ++tbl)
#pragma unroll
            for (int cbk = 0; cbk < 6; ++cbk)
#pragma unroll
                for (int r = 0; r < 4; ++r) part[(w * 96 + 16 * cbk + 4 * fq + r) * 33 + 16 * tbl + fr] = acc[2 * p + tbl][cbk][r];
        __syncthreads();
        { const int tok = F.tid >> 4, j = F.tid & 15, row = r0 + 32 * p + tok; float f = 0.f, x1a = 0.f, x1b = 0.f, x2a = 0.f, x2b = 0.f;
#pragma unroll
          for (int ww = 0; ww < 8; ++ww) { const LAS float* pp = part + ww * 96 * 33 + tok; f += pp[j * 33]; x1a += pp[(16 + 2 * j) * 33]; x1b += pp[(17 + 2 * j) * 33]; x2a += pp[(48 + 2 * j) * 33]; x2b += pp[(49 + 2 * j) * 33]; }
          const float* ssq = (const float*)(ws + WS_CTL) + CW_SSQH + l * MA; const float rs = rsqrtf(((const GAS float*)ssq)[row] * (1.0f / DM) + EPS);
          f *= rs; x1a *= rs; x1b *= rs; x2a *= rs; x2b *= rs;
          const float z = f + ((const GAS float*)P.b_f)[l * 16 + j]; const float lf = fminf(z, 0.f) - log1pf(__expf(-fabsf(z)));
          const bool smp = row >= MP; const int rr = smp ? row - MP : row;
          ((GAS float*)(ws + WS_LOGF))[row * 16 + j] = lf;
          ((GAS float*)(smp ? P.out + O_FLS + (size_t)l * MS * 16 : P.out + O_FLP + (size_t)l * MP * 16))[(size_t)rr * 16 + j] = lf;
          float ss = (x1a * x1a + x1b * x1b) + (x2a * x2a + x2b * x2b);
          ss += swz_xor(ss, SWZ_X1); ss += swz_xor(ss, SWZ_X2); ss += swz_xor(ss, SWZ_X4); ss += swz_xor(ss, SWZ_X8);
          const float rn = rsqrtf(ss * (1.0f / 64) + EPS); const GAS float* gk = (const GAS float*)P.g_kp + l * 64;
          x1a *= rn * gk[2 * j]; x1b *= rn * gk[2 * j + 1]; x2a *= rn * gk[32 + 2 * j]; x2b *= rn * gk[33 + 2 * j];
          const int pos = smp ? PAST + (rr & 15) : (row & (SEQ - 1));
          const f32x4 cs = *(const GAS f32x4*)((const float*)(ws + WS_ROPE) + ((size_t)pos * 32 + 2 * j) * 2);
          const float o1a = x1a * cs[0] - x2a * cs[1], o2a = x2a * cs[0] + x1a * cs[1], o1b = x1b * cs[2] - x2b * cs[3], o2b = x2b * cs[2] + x1b * cs[3];
          float* ko = (smp ? P.out + O_KPES + (size_t)l * MS * 64 : P.out + O_KPEP + (size_t)l * MP * 64) + (size_t)rr * 64;
          *(GAS f32x2*)(ko + 2 * j) = (f32x2){o1a, o1b}; *(GAS f32x2*)(ko + 32 + 2 * j) = (f32x2){o2a, o2b};
          bf16* kb = smp ? (bf16*)(ws + WS_KPES + l * AL(SZ_KPES)) + (size_t)((rr >> 4) * SKV + PAST + (rr & 15)) * 64 : (bf16*)(ws + WS_KPEP) + (size_t)row * 64;
          *(GAS unsigned*)(kb + 2 * j) = cvtpk(o1a, o1b); *(GAS unsigned*)(kb + 32 + 2 * j) = cvtpk(o2a, o2b); }
        __syncthreads();
    }
}
__device__ PH_ATTR void mid_side_jobs(const Frame& F0, const Params& P, int l) {
    PHASE_FRAME(F0);
    unsigned char* ws = opaque_ptr(P.ws);
    { const int bx = (int)blockIdx.x;
      if (F.G == 256) { if (bx >= 156 && bx < 156 + MA / 96) skinny_item(F, P, l, bx - 156); }
      else for (int it = bx; it < MA / 96; it += F.G) skinny_item(F, P, l, it); }
    const int gw = F.vcu * 8 + F.wave, NGW = F.G * 8; const float* ssq = (const float*)(ws + WS_CTL) + CW_SSQCKV + l * MA;
    for (int m = gw; m < MA; m += NGW) { const float rs = rsqrtf(((const GAS float*)ssq)[m] * (1.0f / KVL) + EPS);
        float* o = m < MP ? P.out + O_CKVP + ((size_t)l * MP + m) * KVL : P.out + O_CKVS + ((size_t)l * MS + (m - MP)) * KVL;
#pragma unroll
        for (int j = 0; j < 2; ++j) { f32x4 v = *(GAS f32x4*)(o + 4 * F.lane + 256 * j); v *= rs; *(GAS f32x4*)(o + 4 * F.lane + 256 * j) = v; } }
}
__device__ PH_ATTR void fin_phase(const Frame& F0, const Params& P, int l) {
    PHASE_FRAME(F0);
    unsigned char* ws = opaque_ptr(P.ws); const int gw = F.vcu * 8 + F.wave, NGW = F.G * 8;
    const float* slab = (const float*)(ws + WS_SLAB); float* y0s = (float*)(ws + WS_Y0) + (size_t)MP * DM; float* ssq = (float*)(ws + WS_CTL) + CW_SSQH + MA;
    for (int r = gw; r < MS; r += NGW) { float ss = 0.f;
        const float* rs = l == 0 ? P.x_s + (size_t)r * DM : y0s + (size_t)r * DM; float* dst = l == 0 ? y0s + (size_t)r * DM : P.out + O_YS + (size_t)r * DM;
        f32x4 v[16];
#pragma unroll
        for (int j = 0; j < 16; ++j) v[j] = *(const GAS f32x4*)(rs + 4 * F.lane + 256 * j);
#pragma unroll 4
        for (int k = 0; k < 16; ++k) {
#pragma unroll
            for (int j = 0; j < 16; ++j) v[j] += *(const GAS f32x4*)(slab + ((size_t)k * MS + r) * DM + 4 * F.lane + 256 * j); }
        f32x4 gg[16];
#pragma unroll
        for (int j = 0; j < 16; ++j) gg[j] = *(const GAS f32x4*)(P.g_norm + DM + 4 * F.lane + 256 * j);
#pragma unroll
        for (int j = 0; j < 16; ++j) { const int c = 4 * F.lane + 256 * j;
            *(GAS f32x4*)(dst + c) = v[j];
            if (l == 0) { ss += (v[j][0] * v[j][0] + v[j][1] * v[j][1]) + (v[j][2] * v[j][2] + v[j][3] * v[j][3]); const f32x4 h = v[j] * gg[j];
                u32x2 w = {cvtpk(h[0], h[1]), cvtpk(h[2], h[3])}; *(GAS u32x2*)((bf16*)(ws + WS_H) + (size_t)(MP + r) * HP + c) = w; } }
        if (l == 0) { ss = wave_sum(ss); if (F.lane == 0) ((GAS float*)ssq)[MP + r] = ss; } }
}

__device__ __forceinline__ void att_sample_units(const Frame& F0, const Params& P, int l) {
    PHASE_FRAME(F0);
    unsigned char* ws = opaque_ptr(P.ws); LAS char* lds = (LAS char*)F.lds;
    LAS float* cb = (LAS float*)(lds + att::CB_OFF); LAS float* red = (LAS float*)(lds + att::RED_OFF);
    const bf16* QF = (const bf16*)(ws + WS_QF); const bf16* KF = (const bf16*)(ws + WS_KF); const bf16* VF = (const bf16*)(ws + WS_VF);
    const bf16* GATE = (const bf16*)(ws + WS_GATE); bf16* OB = (bf16*)(ws + WS_O); const bf16* QN = (const bf16*)(ws + WS_QN);
    const bf16* KVP = (const bf16*)(ws + WS_KVP); const bf16* KVS = (const bf16*)(ws + WS_KVS); const bf16* KPEP = (const bf16*)(ws + WS_KPEP);
    const bf16* KPES = (const bf16*)(ws + WS_KPES + l * AL(SZ_KPES)); const float* LOGF = (const float*)(ws + WS_LOGF);
    for (int u = F.vcu; u < DBATCH * 16; u += F.G) { const int b = u >> 4, h = u & 15; const size_t qrow = (size_t)MP + b * DSEQ;
        { float v[5]; const int tid_s = opaque_tid();
#pragma unroll
          for (int e = 0; e < 5; ++e) { const int j = 5 * tid_s + e; v[e] = j < PAST ? ((const GAS float*)P.c_fl)[(((size_t)l * DBATCH + b) * PAST + j) * 16 + h] : (j < SKV ? ((const GAS float*)LOGF)[(qrow + (j - PAST)) * 16 + h] : 0.f); }
          att::block_scan_store<5>(v, cb, red, tid_s); }
        att::attn_small_unit<128, true>(lds, QF + qrow * FW + h * 128, FW, P.c_fk + (((size_t)l * DBATCH + b) * PAST * 16 + h) * 128, P.c_fv + (((size_t)l * DBATCH + b) * PAST * 16 + h) * 128,
                                       KF + qrow * FW + h * 128, VF + qrow * FW + h * 128, nullptr, nullptr, nullptr, GATE + qrow * DM + h * 128, OB + qrow * OP + h * 128);
        att::attn_small_unit<192, false>(lds, QN + qrow * 3072 + h * 192, 3072, nullptr, nullptr, nullptr, nullptr, KVS + (size_t)b * SKV * 4096 + h * 256, KPES + (size_t)b * SKV * 64,
                                        KVS + (size_t)b * SKV * 4096 + h * 256 + 128, GATE + qrow * DM + 2048 + h * 128, OB + qrow * OP + 2048 + h * 128, P.g_kn + l * 128);
    }
}
__device__ __forceinline__ void att_prompt_units(const Frame& F0, const Params& P, int l) {
    PHASE_FRAME(F0);
    unsigned char* ws = opaque_ptr(P.ws); LAS char* lds = (LAS char*)F.lds;
    LAS float* cb = (LAS float*)(lds + att::CB_OFF); LAS float* red = (LAS float*)(lds + att::RED_OFF);
    const bf16* QF = (const bf16*)(ws + WS_QF); const bf16* KF = (const bf16*)(ws + WS_KF); const bf16* VF = (const bf16*)(ws + WS_VF);
    const bf16* GATE = (const bf16*)(ws + WS_GATE); bf16* OB = (bf16*)(ws + WS_O); const bf16* QN = (const bf16*)(ws + WS_QN);
    const bf16* KVP = (const bf16*)(ws + WS_KVP); const bf16* KVS = (const bf16*)(ws + WS_KVS); const bf16* KPEP = (const bf16*)(ws + WS_KPEP);
    const bf16* KPES = (const bf16*)(ws + WS_KPES + l * AL(SZ_KPES)); const float* LOGF = (const float*)(ws + WS_LOGF);
    for (int u = F.vcu; u < NBATCH * 16 * 4; u += F.G) { const int bh = u >> 2, s = u & 3, b = bh >> 4, h = bh & 15; const size_t row0 = (size_t)b * SEQ;
        { float v[4]; const int nk = 256 * (8 - s); const int tid_s = opaque_tid();
#pragma unroll
          for (int e = 0; e < 4; ++e) { const int j = 4 * tid_s + e; v[e] = j < nk ? ((const GAS float*)LOGF)[(row0 + j) * 16 + h] : 0.f; }
          att::block_scan_store<4>(v, cb, red, tid_s); }
#if defined(DUP_FOXBIG)
#pragma unroll 1
        for (int pass = 0; pass < 4; ++pass) { const int qb = (pass & 1) ? s : 7 - s;
#else
#pragma unroll 1
        for (int pass = 0; pass < 2; ++pass) { const int qb = pass ? s : 7 - s;
#endif
            att::attn_big_unit<128, true>(lds, QF + row0 * FW + h * 128, FW, KF + row0 * FW + h * 128, FW, nullptr, 0, VF + row0 * FW + h * 128, FW, GATE + row0 * DM + h * 128, OB + row0 * OP + h * 128, qb); }
#pragma unroll 1
        for (int pass = 0; pass < 2; ++pass) { const int qb = pass ? s : 7 - s;
            att::attn_big_unit<192, false>(lds, QN + row0 * 3072 + h * 192, 3072, KVP + row0 * 4096 + h * 256, 4096, KPEP + row0 * 64, 64, KVP + row0 * 4096 + h * 256 + 128, 4096,
                                          GATE + row0 * DM + 2048 + h * 128, OB + row0 * OP + 2048 + h * 128, qb); }
    }
}
__device__ PH_ATTR void attention_phase(const Frame& F0, const Params& P, int l) {
    if ((F0.vcu & 1) == 0) att_sample_units(F0, P, l);
    att_prompt_units(F0, P, l);
    if ((F0.vcu & 1) != 0) att_sample_units(F0, P, l);
}

#ifndef MK_SPLIT
#define MK_SPLIT 0
#endif
__global__ void __launch_bounds__(512, 2) fwd_kernel(Params P) {
    extern __shared__ __attribute__((aligned(16))) unsigned char lds_raw[];
    Frame F; F.lds = (LAS unsigned char*)lds_raw; F.tid = threadIdx.x; F.lane = F.tid & 63; F.wave = __builtin_amdgcn_readfirstlane(F.tid >> 6);
    F.G = gridDim.x; { const int bx = blockIdx.x; F.vcu = (F.G % 8 == 0) ? (bx % 8) * (F.G / 8) + bx / 8 : bx; }
    volatile LAS unsigned* MISC = (volatile LAS unsigned*)(F.lds + MISC_OFF);
    if (F.tid < 64) MISC[F.tid] = 0u;
    __syncthreads();
#if MK_SPLIT
    const int lo = P.lo, hi = P.hi;
#define IN(k) (lo <= (k) && (k) < hi)
#define SEAM(k) do { } while (0)
#else
    xcd_barrier_post((unsigned*)(P.ws + WS_CTL) + CW_BAR);
#define IN(k) true
#define SEAM(k) xcd_barrier((unsigned*)(P.ws + WS_CTL) + CW_BAR, MISC + 8)
#endif
    LAS float* X = (LAS float*)(F.lds + XCH_OFF);
    if (IN(0)) {
#ifndef NO_P0
        convert_work<0>(F, P);
#endif
    }
    SEAM(0);
#ifdef EXP_NOLOOP
    for (int l = 0; l < 1; ++l) {
#else
#pragma unroll 1
    for (int l = 0; l < DEPTH; ++l) {
#endif
        const int pb = 1 + 5 * l; (void)pb;
        unsigned char* ws = opaque_ptr(P.ws);
        if (IN(pb)) {
#ifndef NO_G1
            const bf16* H = (const bf16*)(ws + WS_H); const bf16* W = (const bf16*)(ws + WS_WIN + l * AL(SZ_WIN));
            { pg8::Epi1qk E{P, l, X}; pg8::gemm_phase<MA, 4096, DM, HP, WP, 0, 1, pg8::WG1>(F.lds, H, W, E); }
            if (l == 0 && (blockIdx.x & 1) == 0) { convert_work<1>(F, P); __syncthreads(); }
            { pg8::Epi1vg E{P, l}; pg8::gemm_phase<MA, 6144, DM, HP, WP, 33 * 16, 1, pg8::WG1>(F.lds, H, W + (size_t)4096 * WP, E); }
            if (l == 0 && (blockIdx.x & 1) != 0) { convert_work<1>(F, P); __syncthreads(); }
            { pg8::Epi1c E{P, l}; pg8::gemm_phase<MA, 1536, DM, HP, WP, 33 * 40, 1, pg8::WG1>(F.lds, H, W + (size_t)10240 * WP, E); }

#endif
        }
        SEAM(pb);
        if (IN(pb + 1)) {
#ifndef NO_SIDE
            mid_side_jobs(F, P, l);
#if defined(DUP_SIDE)
            { const int bx = (int)blockIdx.x;
      if (F.G == 256) { skinny_item(F, P, l, bx); if (bx >= 248) skinny_item(F, P, l, 256 + bx - 248); }
      else for (int it = bx; it < MA / 32; it += F.G) skinny_item(F, P, l, it); }
#endif
#endif
#ifndef NO_G2
            { pg8::Epi2a E{P, l, X}; pg8::gemm_phase<MA, 3072, QL, QL, QL, 0, 1, pg8::WG2>(F.lds, (const bf16*)(ws + WS_CQG), (const bf16*)(ws + WS_WQB + l * AL(SZ_WQB)), E); }
            { pg8::Epi2k E{P, l, X}; pg8::gemm_phase<MA, 4096, KVL, KVL, KVL, 33 * 12, 1, pg8::WG2>(F.lds, (const bf16*)(ws + WS_CKVA + l * AL(SZ_CKVA)), (const bf16*)(ws + WS_WKVB + l * AL(SZ_WKVB)), E); }
            { pg8::Epi2c E{P, l}; pg8::gemm_phase<DBATCH * PAST, 4096, KVL, KVL, KVL, 33 * 12 + 33 * 16, 1, pg8::WG2C>(F.lds, (const bf16*)(ws + WS_CKVA + l * AL(SZ_CKVA)) + (size_t)MA * KVL, (const bf16*)(ws + WS_WKVB + l * AL(SZ_WKVB)), E); }

#endif
        }
        SEAM(pb + 1);
        if (IN(pb + 2)) {
#ifndef NO_ATT
            attention_phase(F, P, l);
#if defined(DUP_ATT)
            __syncthreads(); attention_phase(F, P, l);
#endif
#endif
        }
        SEAM(pb + 2);
        if (IN(pb + 3)) {
#ifndef NO_G3
            { pg8::Epi3 E{P, l, false}; pg8::gemm_phase<MP, DM, DM, OP, WP, 0, 1, pg8::WG3>(F.lds, (const bf16*)(ws + WS_O), (const bf16*)(ws + WS_WOUT + l * AL(SZ_WOUT)), E); }
#if defined(DUP_G3)
            { pg8::Epi3 E{P, l, true}; pg8::gemm_phase<MP, DM, DM, OP, WP, 0, 1, pg8::WG3>(F.lds, (const bf16*)(ws + WS_O), (const bf16*)(ws + WS_WOUT + l * AL(SZ_WOUT)), E); }
#endif
#ifndef EXP_NOSPLITK
            { pg8::Epi3s E{P, l}; pg8::gemm_phase<MS, DM, 256, OP, WP, 512, 16, pg8::WG3>(F.lds, (const bf16*)(ws + WS_O) + (size_t)MP * OP, (const bf16*)(ws + WS_WOUT + l * AL(SZ_WOUT)), E); }
#endif
#endif
        }
        SEAM(pb + 3);
        if (IN(pb + 4)) fin_phase(F, P, l);
        if (l == 0) SEAM(pb + 4);
    }
#undef IN
#undef SEAM
}

extern "C" void kernel_launch(void* const* d_in, const int* in_sizes, int n_in, void* d_out, int out_size, void* d_ws, size_t ws_size, hipStream_t stream) {
    static int grid = 0;
    if (grid == 0) {
        if (n_in != 21 || (size_t)out_size != O_END || ws_size < WS_END) { fprintf(stderr, "kernel_launch: unexpected shapes (n_in %d, out %d, ws %zu; need 21, %zu, >= %zu)\n", n_in, out_size, ws_size, (size_t)O_END, (size_t)WS_END); grid = -1; return; }
        int dev = 0, cus = 0, per_cu = 0;
        if (hipGetDevice(&dev) != hipSuccess || hipDeviceGetAttribute(&cus, hipDeviceAttributeMultiprocessorCount, dev) != hipSuccess) { grid = -1; return; }
        if (hipFuncSetAttribute((const void*)fwd_kernel, hipFuncAttributeMaxDynamicSharedMemorySize, LDS_BYTES) != hipSuccess) { fprintf(stderr, "kernel_launch: hipFuncSetAttribute failed\n"); grid = -1; return; }
        if (hipOccupancyMaxActiveBlocksPerMultiprocessor(&per_cu, (const void*)fwd_kernel, 512, LDS_BYTES) != hipSuccess || per_cu < 1) fprintf(stderr, "kernel_launch: occupancy query says %d\n", per_cu);
        (void)hipGetLastError();
        grid = cus;
    }
    if (grid < 0) return;
    if (hipMemsetAsync((char*)d_ws + WS_CTL, 0, (((size_t)(CW_SSQCKV + 2 * MA) * 4 + 4095) / 4096) * 4096, stream) != hipSuccess) return;
    Params p{};
    const float** pf = (const float**)&p;
    for (int i = 0; i < 21; ++i) pf[i] = (const float*)d_in[i];
    p.out = (float*)d_out; p.ws = (unsigned char*)d_ws;
#if MK_SPLIT
    for (int ph = 0; ph <= 10; ++ph) { if (ph == 10) continue; p.lo = ph; p.hi = ph + 1; hipLaunchKernelGGL(fwd_kernel, dim3(grid), dim3(512), LDS_BYTES, stream, p); }
#else
    p.lo = 0; p.hi = 11;
    hipLaunchKernelGGL(fwd_kernel, dim3(grid), dim3(512), LDS_BYTES, stream, p);
#endif
}
```
